# Optimizing an MI355X kernel written in HIP

```python
import math
import jax, jax.numpy as jnp
from jax import lax
import numpy as np

D_MODEL = 1024
BATCH = 32
SEQ = 256
DEPTH = 2
DEC_BATCH = 2
DEC_SEQ = 4096
PAST_LEN = 256

GRID_W = 64
MIX = D_MODEL
D_HY = D_MODEL // 4
D_NA = D_MODEL // 2
D_S5 = D_MODEL // 4
HYENA_ORDER = 2
HY_SHORT_CONV = 3
HY_BANDS = 16
HY_FEAT = 1 + 2 * HY_BANDS
HY_FILTER_HIDDEN = 64
HY_DECAY_SLOW = math.log(100.0) / 1.5
HY_DECAY_FAST = math.log(100.0) / 0.3
NA_HEAD_DIM = 64
NA_HEADS = D_NA // NA_HEAD_DIM
WIN_R_MAX = 8
WIN_C = 16
Q_COLS = 16
BAND = 32
N_COL_BLOCKS = GRID_W // Q_COLS
ROPE_BASE = 10000.0
ROPE_PAIRS = NA_HEAD_DIM // 4
Q_BLOCK = 128
S5_CH = 16
S5_GROUPS = D_S5 // S5_CH
S5_STATE = 64
S5_DT_MIN = 1e-3
S5_DT_MAX = 1e-1
IN_WIDTH = 3 * D_HY + 3 * D_NA + D_S5 + MIX
EPS = 1e-6
F32 = jnp.float32

kernel_name = 'hyena_natten_s5_prefix_dit_step'


def _rms_norm(x, g):
    x32 = x.astype(F32)
    y = x32 * lax.rsqrt(jnp.mean(x32 * x32, axis=-1, keepdims=True) + EPS)
    return (y * g.astype(F32)).astype(x.dtype)


def _pre(x, mod, norm_g, in_w):
    shift, scale, gate = jnp.split(mod, 3, axis=-1)
    h = _rms_norm(x, norm_g) * (1 + scale) + shift
    return h @ in_w, gate


def _split_proj(z):
    o1 = 3 * D_HY
    o2 = o1 + D_NA
    o3 = o2 + D_NA
    o4 = o3 + D_NA
    o5 = o4 + D_S5
    return jnp.split(z, [o1, o2, o3, o4, o5], axis=-1)


def _heads(t):
    b, l, _ = t.shape
    return t.reshape(b, l, NA_HEADS, NA_HEAD_DIM).transpose(0, 2, 1, 3)


def _merge(t):
    b, h, l, d = t.shape
    return t.transpose(0, 2, 1, 3).reshape(b, l, h * d)


def _post(x, y_hy, y_na, y_s5, g, res_gate, out_w):
    y = jnp.concatenate([y_hy, y_na, y_s5], axis=-1) * jax.nn.silu(g)
    return x + res_gate * (y @ out_w)


def _hyena_filter_spectra(L, f_w1, f_b1, f_w2, f_b2, f_freq, f_w3, decay):
    t = jnp.arange(L, dtype=F32) / L
    ang = 2.0 * jnp.pi * t[:, None] * jnp.arange(1, HY_BANDS + 1, dtype=F32)
    feat = jnp.concatenate([t[:, None], jnp.cos(ang), jnp.sin(ang)], axis=-1)
    freq = f_freq.astype(F32)
    h = jnp.sin(freq * (feat @ f_w1.astype(F32) + f_b1.astype(F32)))
    h = jnp.sin(freq * (h @ f_w2.astype(F32) + f_b2.astype(F32)))
    h = (h @ f_w3.astype(F32)) * jnp.exp(-t[:, None] * jnp.abs(decay.astype(F32)))
    h = h.reshape(L, HYENA_ORDER, 2, D_HY)
    h_fwd, h_bwd = h[:, :, 0], h[:, :, 1]
    taps = jnp.concatenate([h_fwd, jnp.zeros((1, HYENA_ORDER, D_HY), F32), h_bwd[:0:-1]], axis=0)
    taps = taps / jnp.sum(jnp.abs(taps), axis=0, keepdims=True)
    return jnp.fft.rfft(taps, axis=0)


def _fft_conv(u, spec):
    L = u.shape[1]
    U = jnp.fft.rfft(u, n=2 * L, axis=1)
    return jnp.fft.irfft(U * spec[None], n=2 * L, axis=1)[:, :L]


def _hyena(zh, lp):
    L = zh.shape[1]
    w = lp['hy_conv_w']
    pad = HY_SHORT_CONV // 2
    zp = jnp.pad(zh, ((0, 0), (pad, pad), (0, 0)))
    zc = lp['hy_conv_b'] + sum(zp[:, j:j + L] * w[j] for j in range(HY_SHORT_CONV))
    v, x1, x2 = jnp.split(zc.astype(F32), 3, axis=-1)
    spec = _hyena_filter_spectra(L, lp['hy_f_w1'], lp['hy_f_b1'], lp['hy_f_w2'], lp['hy_f_b2'],
                                 lp['hy_f_freq'], lp['hy_f_w3'], lp['hy_decay'])
    bias = lp['hy_bias'].astype(F32)
    z = v
    for o, gate in enumerate((x1, x2)):
        z = gate * (_fft_conv(z, spec[:, o]) + bias[o] * z)
    return z.astype(zh.dtype)


def _rotate(x, ang):
    cos = jnp.cos(ang).astype(x.dtype)
    sin = jnp.sin(ang).astype(x.dtype)
    x1, x2 = jnp.split(x, 2, axis=-1)
    return jnp.concatenate([x1 * cos - x2 * sin, x2 * cos + x1 * sin], axis=-1)


def _axial_rope(x):
    T = x.shape[-2]
    t = jnp.arange(T)
    row = (t // GRID_W).astype(F32)
    col = (t % GRID_W).astype(F32)
    inv = ROPE_BASE ** (-jnp.arange(ROPE_PAIRS, dtype=F32) / ROPE_PAIRS)
    xr, xc = jnp.split(x, 2, axis=-1)
    return jnp.concatenate([_rotate(xr, row[:, None] * inv), _rotate(xc, col[:, None] * inv)], axis=-1)


def _dense_attention(q, k, v):
    b, h, L, d = q.shape
    scale = d ** -0.5
    qb = jnp.moveaxis(q.reshape(b, h, L // Q_BLOCK, Q_BLOCK, d), 2, 0)

    def blk(qi):
        s = jnp.einsum('bhqd,bhkd->bhqk', qi, k, preferred_element_type=F32) * scale
        p = jax.nn.softmax(s, axis=-1).astype(v.dtype)
        return jnp.einsum('bhqk,bhkd->bhqd', p, v)

    o = lax.map(blk, qb)
    return jnp.moveaxis(o, 0, 2).reshape(b, h, L, d)


def _band_tables():
    qcol = np.arange(GRID_W).reshape(N_COL_BLOCKS, Q_COLS)
    cstart = np.clip(qcol - WIN_C // 2, 0, GRID_W - WIN_C)
    bstart = np.clip(qcol[:, 0] - WIN_C // 2, 0, GRID_W - BAND)
    bcol = bstart[:, None] + np.arange(BAND)
    off = bcol[:, None, :] - qcol[:, :, None]
    valid = (bcol[:, None, :] >= cstart[:, :, None]) & (bcol[:, None, :] < cstart[:, :, None] + WIN_C)
    col_idx = np.clip(off, -(WIN_C - 1), WIN_C - 1) + (WIN_C - 1)
    return bcol, col_idx, valid


def _na_latent(q_rot, q_raw, k_rot, v, k_ctx, v_ctx, rpb):
    b, h, T, d = q_rot.shape
    R = T // GRID_W
    wr = min(WIN_R_MAX, R)
    scale = d ** -0.5
    bcol, col_idx, valid = _band_tables()
    kg = k_rot.reshape(b, h, R, GRID_W, d)
    vg = v.reshape(b, h, R, GRID_W, d)

    def per_row(a):
        return jnp.moveaxis(a.reshape(b, h, R, N_COL_BLOCKS, Q_COLS, d), 2, 0)

    valid_j = jnp.asarray(valid)[:, :, None, :]
    rpb_cols = rpb.astype(F32)[:, :, col_idx]

    def row_block(args):
        r, qr, qc = args
        rs = jnp.clip(r - wr // 2, 0, R - wr)
        kb = lax.dynamic_slice_in_dim(kg, rs, wr, axis=2)[:, :, :, bcol]
        vb = lax.dynamic_slice_in_dim(vg, rs, wr, axis=2)[:, :, :, bcol]
        s_win = jnp.einsum('bhnqd,bhrnkd->bhnqrk', qr, kb, preferred_element_type=F32) * scale
        row_idx = rs + jnp.arange(wr) - r + (WIN_R_MAX - 1)
        bias = jnp.take(rpb_cols, row_idx, axis=1).transpose(0, 2, 3, 1, 4)
        s_win = jnp.where(valid_j, s_win + bias, -jnp.inf)
        s_win = s_win.reshape(b, h, N_COL_BLOCKS, Q_COLS, wr * BAND)
        s_ctx = jnp.einsum('bhnqd,bhld->bhnql', qc, k_ctx, preferred_element_type=F32) * scale
        p = jax.nn.softmax(jnp.concatenate([s_win, s_ctx], axis=-1), axis=-1).astype(v.dtype)
        p_win = p[..., :wr * BAND].reshape(b, h, N_COL_BLOCKS, Q_COLS, wr, BAND)
        p_ctx = p[..., wr * BAND:]
        o = (jnp.einsum('bhnqrk,bhrnkd->bhnqd', p_win, vb)
             + jnp.einsum('bhnql,bhld->bhnqd', p_ctx, v_ctx))
        return o.reshape(b, h, GRID_W, d)

    out = lax.map(row_block, (jnp.arange(R), per_row(q_rot), per_row(q_raw)))
    return jnp.moveaxis(out, 0, 2).reshape(b, h, T, d)


def _diag_scan(lam_bar, bu, s0):
    a = jnp.broadcast_to(lam_bar, bu.shape)

    def combine(left, right):
        return left[0] * right[0], right[0] * left[1] + right[1]

    a_cum, s = lax.associative_scan(combine, (a, bu), axis=1)
    return s + a_cum * s0[:, None]


def _s5(u, s0_re, s0_im, lp):
    b, L, _ = u.shape
    u32 = u.astype(F32)
    ug = u32.reshape(b, L, S5_GROUPS, S5_CH).astype(jnp.complex64)
    lam = lax.complex(lp['s5_a_re'].astype(F32), lp['s5_a_im'].astype(F32))
    dt = jnp.exp(lp['s5_log_dt'].astype(F32))[..., None]
    lam_bar = jnp.exp(lam * dt)
    b_mat = lax.complex(lp['s5_b_re'].astype(F32), lp['s5_b_im'].astype(F32))
    b_bar = ((lam_bar - 1.0) / lam)[..., None] * b_mat
    c_mat = lax.complex(lp['s5_c_re'].astype(F32), lp['s5_c_im'].astype(F32))
    s0 = lax.complex(s0_re.astype(F32), s0_im.astype(F32))
    bu = jnp.einsum('blgc,egpc->eblgp', ug, b_bar)
    s_f = _diag_scan(lam_bar[0], bu[0], s0[:, 0])
    s_b = _diag_scan(lam_bar[1], bu[1][:, ::-1], s0[:, 1])[:, ::-1]
    y = (jnp.einsum('blgp,gcp->blgc', s_f, c_mat[0])
         + jnp.einsum('blgp,gcp->blgc', s_b, c_mat[1])).real
    y = y.reshape(b, L, D_S5) + lp['s5_d'].astype(F32) * u32
    y = jax.nn.gelu(y)
    y = y * jax.nn.sigmoid(y @ lp['s5_glu_w'].astype(F32) + lp['s5_glu_b'].astype(F32))
    fin = jnp.stack([s_f[:, -1], s_b[:, 0]], axis=1)
    return y.astype(u.dtype), fin.real.astype(u.dtype), fin.imag.astype(u.dtype)


def _context_layer(x, mod, lp):
    b = x.shape[0]
    z, res_gate = _pre(x, mod, lp['norm_g'], lp['in_w'])
    zh, q, k, v, su, g = _split_proj(z)
    y_hy = _hyena(zh, lp)
    qh, kh, vh = _heads(q), _heads(k), _heads(v)
    y_na = _merge(_dense_attention(qh, kh, vh))
    s0 = jnp.zeros((b, 2, S5_GROUPS, S5_STATE), F32)
    y_s5, fin_re, fin_im = _s5(su, s0, s0, lp)
    x = _post(x, y_hy, y_na, y_s5, g, res_gate, lp['out_w'])
    return x, kh, vh, fin_re, fin_im


def _latent_layer(x, mod, k_ctx, v_ctx, s0_re, s0_im, lp):
    z, res_gate = _pre(x, mod, lp['norm_g'], lp['in_w'])
    zh, q, k, v, su, g = _split_proj(z)
    y_hy = _hyena(zh, lp)
    qh, kh, vh = _heads(q), _heads(k), _heads(v)
    y_na = _merge(_na_latent(_axial_rope(qh), qh, _axial_rope(kh), vh, k_ctx, v_ctx, lp['na_rpb']))
    y_s5, _, _ = _s5(su, s0_re, s0_im, lp)
    return _post(x, y_hy, y_na, y_s5, g, res_gate, lp['out_w'])


def setup_inputs(seed: int = 0) -> dict:
    key = jax.random.key(seed)
    ks = jax.random.split(key, 35)

    def nrm(i, shape, s=1.0):
        return jax.random.normal(ks[i], shape, F32) * s

    decay_base = jnp.concatenate(
        [jnp.linspace(HY_DECAY_SLOW, HY_DECAY_FAST, D_HY, dtype=F32)] * (HYENA_ORDER * 2))
    return {
        'x_prompt': nrm(0, (BATCH, SEQ, D_MODEL)),
        'x_sample': nrm(1, (DEC_BATCH, DEC_SEQ, D_MODEL)),
        'cache_k': nrm(2, (DEC_BATCH, DEPTH, NA_HEADS, PAST_LEN, NA_HEAD_DIM)),
        'cache_v': nrm(3, (DEC_BATCH, DEPTH, NA_HEADS, PAST_LEN, NA_HEAD_DIM)),
        'state_s5_re': nrm(4, (DEC_BATCH, DEPTH, 2, S5_GROUPS, S5_STATE), 0.1),
        'state_s5_im': nrm(5, (DEC_BATCH, DEPTH, 2, S5_GROUPS, S5_STATE), 0.1),
        'c': nrm(6, (DEC_BATCH, D_MODEL)),
        'c_ctx': nrm(7, (D_MODEL,)),
        'norm_g': 1.0 + nrm(8, (DEPTH, D_MODEL), 0.02),
        'ada_w': nrm(9, (DEPTH, D_MODEL, 3 * D_MODEL), D_MODEL ** -0.5),
        'ada_b': nrm(10, (DEPTH, 3 * D_MODEL), 0.02),
        'in_w': nrm(11, (DEPTH, D_MODEL, IN_WIDTH), D_MODEL ** -0.5),
        'out_w': nrm(12, (DEPTH, MIX, D_MODEL), MIX ** -0.5),
        'hy_conv_w': nrm(13, (DEPTH, HY_SHORT_CONV, 3 * D_HY), HY_SHORT_CONV ** -0.5),
        'hy_conv_b': nrm(14, (DEPTH, 3 * D_HY), 0.02),
        'hy_f_w1': nrm(15, (DEPTH, HY_FEAT, HY_FILTER_HIDDEN), HY_FEAT ** -0.5),
        'hy_f_b1': nrm(16, (DEPTH, HY_FILTER_HIDDEN), 0.1),
        'hy_f_w2': nrm(17, (DEPTH, HY_FILTER_HIDDEN, HY_FILTER_HIDDEN), HY_FILTER_HIDDEN ** -0.5),
        'hy_f_b2': nrm(18, (DEPTH, HY_FILTER_HIDDEN), 0.1),
        'hy_f_freq': 1.0 + nrm(19, (DEPTH, HY_FILTER_HIDDEN), 0.02),
        'hy_f_w3': nrm(20, (DEPTH, HY_FILTER_HIDDEN, HYENA_ORDER * 2 * D_HY), HY_FILTER_HIDDEN ** -0.5),
        'hy_decay': decay_base[None] + nrm(21, (DEPTH, HYENA_ORDER * 2 * D_HY), 0.05),
        'hy_bias': nrm(22, (DEPTH, HYENA_ORDER, D_HY)),
        'na_rpb': nrm(23, (DEPTH, NA_HEADS, 2 * WIN_R_MAX - 1, 2 * WIN_C - 1), 0.1),
        's5_a_re': -0.5 + nrm(24, (DEPTH, 2, S5_GROUPS, S5_STATE), 0.01),
        's5_a_im': jnp.pi * jnp.arange(S5_STATE, dtype=F32) + nrm(25, (DEPTH, 2, S5_GROUPS, S5_STATE), 0.01),
        's5_log_dt': jax.random.uniform(ks[26], (DEPTH, 2, S5_GROUPS), F32,
                                        minval=math.log(S5_DT_MIN), maxval=math.log(S5_DT_MAX)),
        's5_b_re': nrm(27, (DEPTH, 2, S5_GROUPS, S5_STATE, S5_CH), (2 * S5_CH) ** -0.5),
        's5_b_im': nrm(28, (DEPTH, 2, S5_GROUPS, S5_STATE, S5_CH), (2 * S5_CH) ** -0.5),
        's5_c_re': nrm(29, (DEPTH, 2, S5_GROUPS, S5_CH, S5_STATE), S5_STATE ** -0.5),
        's5_c_im': nrm(30, (DEPTH, 2, S5_GROUPS, S5_CH, S5_STATE), S5_STATE ** -0.5),
        's5_d': nrm(31, (DEPTH, D_S5)),
        's5_glu_w': nrm(32, (DEPTH, D_S5, D_S5), D_S5 ** -0.5),
        's5_glu_b': nrm(33, (DEPTH, D_S5), 0.02),
        'final_norm_g': 1.0 + nrm(34, (D_MODEL,), 0.02),
    }


def reference(x_prompt, x_sample, cache_k, cache_v, state_s5_re, state_s5_im, c, c_ctx,
              norm_g, ada_w, ada_b, in_w, out_w, hy_conv_w, hy_conv_b, hy_f_w1, hy_f_b1,
              hy_f_w2, hy_f_b2, hy_f_freq, hy_f_w3, hy_decay, hy_bias, na_rpb,
              s5_a_re, s5_a_im, s5_log_dt, s5_b_re, s5_b_im, s5_c_re, s5_c_im, s5_d,
              s5_glu_w, s5_glu_b, final_norm_g):
    xp = x_prompt
    xs = x_sample
    new_k, new_v, new_re, new_im = [], [], [], []
    for l in range(DEPTH):
        lp = {
            'norm_g': norm_g[l], 'in_w': in_w[l], 'out_w': out_w[l],
            'hy_conv_w': hy_conv_w[l], 'hy_conv_b': hy_conv_b[l],
            'hy_f_w1': hy_f_w1[l], 'hy_f_b1': hy_f_b1[l], 'hy_f_w2': hy_f_w2[l], 'hy_f_b2': hy_f_b2[l],
            'hy_f_freq': hy_f_freq[l], 'hy_f_w3': hy_f_w3[l], 'hy_decay': hy_decay[l], 'hy_bias': hy_bias[l],
            'na_rpb': na_rpb[l],
            's5_a_re': s5_a_re[l], 's5_a_im': s5_a_im[l], 's5_log_dt': s5_log_dt[l],
            's5_b_re': s5_b_re[l], 's5_b_im': s5_b_im[l], 's5_c_re': s5_c_re[l], 's5_c_im': s5_c_im[l],
            's5_d': s5_d[l], 's5_glu_w': s5_glu_w[l], 's5_glu_b': s5_glu_b[l],
        }
        mod_ctx = (jax.nn.silu(c_ctx) @ ada_w[l] + ada_b[l])[None, None, :]
        xp, kc, vc, fre, fim = _context_layer(xp, mod_ctx, lp)
        new_k.append(kc)
        new_v.append(vc)
        new_re.append(fre)
        new_im.append(fim)
        mod_lat = (jax.nn.silu(c) @ ada_w[l] + ada_b[l])[:, None, :]
        xs = _latent_layer(xs, mod_lat, cache_k[:, l], cache_v[:, l],
                           state_s5_re[:, l], state_s5_im[:, l], lp)
    y_prompt = _rms_norm(xp, final_norm_g)
    y_sample = _rms_norm(xs, final_norm_g)
    new_cache_k = jnp.stack(new_k, axis=1)
    new_cache_v = jnp.stack(new_v, axis=1)
    new_state_s5_re = jnp.stack(new_re, axis=1)
    new_state_s5_im = jnp.stack(new_im, axis=1)
    return (y_prompt, y_sample, new_cache_k, new_cache_v, new_state_s5_re, new_state_s5_im)
```

```cpp
#include <hip/hip_runtime.h>
#include <hip/hip_cooperative_groups.h>
#include <cstdio>
namespace cg = cooperative_groups;

typedef unsigned short u16;
using bf16x8 = __attribute__((ext_vector_type(8))) short;
using f32x4 = __attribute__((ext_vector_type(4))) float;
using f32x16 = __attribute__((ext_vector_type(16))) float;
using u32x4 = __attribute__((ext_vector_type(4))) unsigned;
using u32x2 = __attribute__((ext_vector_type(2))) unsigned;

struct KArgs { const float* in[35]; float* out; char* ws; };
struct Params {
  const unsigned long long* tab;
  __device__ __forceinline__ unsigned long long get(int i) const {
    unsigned long long v = tab[i];
    unsigned lo = __builtin_amdgcn_readfirstlane((unsigned)v), hi = __builtin_amdgcn_readfirstlane((unsigned)(v >> 32));
    return ((unsigned long long)hi << 32) | lo;
  }
  __device__ __forceinline__ const float* in(int i) const { return (const float*)get(i); }
  __device__ __forceinline__ float* out() const { return (float*)get(35); }
  __device__ __forceinline__ char* ws() const { return (char*)get(36); }
};

constexpr size_t OFF_MOD   = 0;
constexpr size_t OFF_WINT  = OFF_MOD   + 73728;
constexpr size_t OFF_WOUTT = OFF_WINT  + 14680064;
constexpr size_t OFF_GLUT  = OFF_WOUTT + 4194304;
constexpr size_t OFF_HBF   = OFF_GLUT  + 262144;
constexpr size_t OFF_Z     = OFF_HBF   + 33554432;
constexpr size_t OFF_QROT  = OFF_Z     + 117440512;
constexpr size_t OFF_VT    = OFF_QROT  + 8388608;
constexpr size_t OFF_TAPS  = OFF_VT    + 16777216;
constexpr size_t TAPS_LAYER = 8388608 + 524288;
constexpr size_t OFF_PSUM  = OFF_TAPS  + 2 * TAPS_LAYER;
constexpr size_t PSUM_LAYER = (128 + 8) * 1024 * 4;
constexpr size_t OFF_CKB   = OFF_PSUM  + 2 * PSUM_LAYER;
constexpr size_t OFF_CVT   = OFF_CKB   + 1048576;
constexpr size_t OFF_ROPE  = OFF_CVT   + 1048576;
constexpr size_t OFF_S5KK  = OFF_ROPE  + 8192;
constexpr size_t OFF_S5E   = OFF_S5KK  + 1048576;
constexpr size_t OFF_S5G   = OFF_S5E   + 8388608;
constexpr size_t OFF_YG    = OFF_S5G   + 8388608;
constexpr size_t OFF_EU    = OFF_YG    + 8388608;
constexpr size_t OFF_SIN   = OFF_EU    + 8388608;
constexpr size_t WS_TOTAL  = OFF_SIN   + 4194304;

constexpr int ZW = 3584;
constexpr size_t OUT_K = 16777216, OUT_V = 25165824, OUT_SRE = 33554432, OUT_SIM = 33685504;
constexpr int LDS_BYTES = 40960;

__device__ __forceinline__ int opq_v(int x) { asm volatile("" : "+v"(x)); return x; }
__device__ __forceinline__ int opq_s(int x) { asm volatile("" : "+s"(x)); return x; }
__device__ __forceinline__ u16 f2bf(float f) { unsigned u = __float_as_uint(f); u += 0x7fffu + ((u >> 16) & 1u); return (u16)(u >> 16); }
__device__ __forceinline__ float bf2f(u16 h) { return __uint_as_float(((unsigned)h) << 16); }
__device__ __forceinline__ unsigned pack2(float a, float b) { return (unsigned)f2bf(a) | ((unsigned)f2bf(b) << 16); }
__device__ __forceinline__ float silu_f(float x) { return x / (1.f + __expf(-x)); }
__device__ __forceinline__ float warp_sum(float v) { for (int o = 32; o > 0; o >>= 1) v += __shfl_xor(v, o); return v; }
__device__ __forceinline__ f32x16 mfma32(bf16x8 a, bf16x8 b, f32x16 c) { return __builtin_amdgcn_mfma_f32_32x32x16_bf16(a, b, c, 0, 0, 0); }
__device__ __forceinline__ f32x4 mfma16(bf16x8 a, bf16x8 b, f32x4 c) { return __builtin_amdgcn_mfma_f32_16x16x32_bf16(a, b, c, 0, 0, 0); }
__device__ __forceinline__ bf16x8 ld16(const u16* p) { return *reinterpret_cast<const bf16x8*>(p); }
__device__ __forceinline__ bf16x8 zero8() { bf16x8 z = {0, 0, 0, 0, 0, 0, 0, 0}; return z; }
__device__ __forceinline__ float bfl(unsigned w) { return __uint_as_float(w << 16); }
__device__ __forceinline__ float bfh(unsigned w) { return __uint_as_float(w & 0xffff0000u); }

__device__ __forceinline__ const float* xrow(const Params& p, int l, int row) {
  if (l == 0) return row < 8192 ? p.in(0) + (size_t)row * 1024 : p.in(1) + (size_t)(row - 8192) * 1024;
  return p.out() + (size_t)row * 1024;
}
__device__ __forceinline__ int cond_of(int row) { return row < 8192 ? 0 : 1 + ((row - 8192) >> 12); }

__device__ __forceinline__ void p0_mod(const Params& p, int item, float* lds) {
  const int TIDX = opq_v(threadIdx.x);
  int l = item / 48, n0 = (item % 48) * 64;
  int col = TIDX & 63, ks = TIDX >> 6;
  const float* W = p.in(9) + (size_t)l * 1024 * 3072;
  const float* cc = p.in(6);
  const float* cx = p.in(7);
  float a0 = 0, a1 = 0, a2 = 0;
  for (int k = ks * 256; k < ks * 256 + 256; ++k) {
    float w = W[(size_t)k * 3072 + n0 + col];
    a0 += silu_f(cx[k]) * w; a1 += silu_f(cc[k]) * w; a2 += silu_f(cc[1024 + k]) * w;
  }
  lds[(ks * 3 + 0) * 64 + col] = a0; lds[(ks * 3 + 1) * 64 + col] = a1; lds[(ks * 3 + 2) * 64 + col] = a2;
  __syncthreads();
  if (TIDX < 192) {
    int cnd = TIDX >> 6;
    float s = 0;
    for (int q = 0; q < 4; ++q) s += lds[(q * 3 + cnd) * 64 + col];
    ((float*)(p.ws() + OFF_MOD))[(l * 3 + cnd) * 3072 + n0 + col] = s + p.in(10)[l * 3072 + n0 + col];
  }
  __syncthreads();
}

__device__ __forceinline__ void p0_tr(const float* src, int ldsrc, u16* dst, int lddst, int k0, int n0, float* lds) {
  const int TIDX = opq_v(threadIdx.x);
  for (int e = TIDX; e < 4096; e += 256) { int kk = e >> 6, nn = e & 63; lds[kk * 65 + nn] = src[(size_t)(k0 + kk) * ldsrc + n0 + nn]; }
  __syncthreads();
  for (int e = TIDX; e < 4096; e += 256) { int nn = e >> 6, kk = e & 63; dst[(size_t)(n0 + nn) * lddst + k0 + kk] = f2bf(lds[kk * 65 + nn]); }
  __syncthreads();
}

__device__ __forceinline__ void p0_filter(const Params& p, int l, int lsel, int chunk, float* lds) {
  const int TIDX = opq_v(threadIdx.x);
  const int L = lsel ? 4096 : 256;
  const int t0 = chunk * 32;
  float* feat = lds;
  float* h1 = lds + 1056;
  float* h2 = h1 + 2048;
  const float* w1 = p.in(15) + l * 33 * 64; const float* b1 = p.in(16) + l * 64;
  const float* w2 = p.in(17) + l * 64 * 64; const float* b2 = p.in(18) + l * 64;
  const float* fq = p.in(19) + l * 64;
  const float* w3 = p.in(20) + (size_t)l * 64 * 1024;
  const float* dec = p.in(21) + l * 1024;
  for (int e = TIDX; e < 32 * 33; e += 256) {
    int r = e / 33, f = e % 33; int ti = t0 + r; float v;
    if (f == 0) v = (float)ti / (float)L;
    else {
      int band = f <= 16 ? f : f - 16;
      int rem = (ti * band) % L;
      float ang = 6.283185307179586f * ((float)rem / (float)L);
      v = f <= 16 ? cosf(ang) : sinf(ang);
    }
    feat[e] = v;
  }
  __syncthreads();
  for (int e = TIDX; e < 2048; e += 256) {
    int r = e >> 6, j = e & 63; float s = b1[j];
    for (int f = 0; f < 33; ++f) s += feat[r * 33 + f] * w1[f * 64 + j];
    h1[e] = sinf(fq[j] * s);
  }
  __syncthreads();
  for (int e = TIDX; e < 2048; e += 256) {
    int r = e >> 6, j = e & 63; float s = b2[j];
    for (int k = 0; k < 64; ++k) s += h1[r * 64 + k] * w2[k * 64 + j];
    h2[e] = sinf(fq[j] * s);
  }
  __syncthreads();
  u16* taps = (u16*)(p.ws() + OFF_TAPS + l * TAPS_LAYER + (lsel ? 0 : 8388608));
  float* psum = (float*)(p.ws() + OFF_PSUM + l * PSUM_LAYER) + (lsel ? 0 : 128 * 1024) + chunk * 1024;
  for (int q = 0; q < 4; ++q) {
    int col = q * 256 + TIDX;
    float w[64];
#pragma unroll
    for (int k = 0; k < 64; ++k) w[k] = w3[k * 1024 + col];
    float ad = fabsf(dec[col]);
    bool isb = (col & 256) != 0;
    float asum = 0;
    for (int r8 = 0; r8 < 4; ++r8) {
      unsigned pk[4];
#pragma unroll
      for (int rr = 0; rr < 8; ++rr) {
        int r = r8 * 8 + rr;
        float s = 0;
#pragma unroll
        for (int k = 0; k < 64; ++k) s += h2[r * 64 + k] * w[k];
        int ti = t0 + r;
        s *= __expf(-((float)ti / (float)L) * ad);
        if (!(isb && ti == 0)) asum += fabsf(s);
        u16 hb = f2bf(s);
        if (rr & 1) pk[rr >> 1] |= ((unsigned)hb) << 16; else pk[rr >> 1] = hb;
      }
      u32x4 v = {pk[0], pk[1], pk[2], pk[3]};
      *reinterpret_cast<u32x4*>(taps + (size_t)col * L + t0 + r8 * 8) = v;
    }
    psum[col] = asum;
  }
  __syncthreads();
}

__device__ __forceinline__ void p0_s5(const Params& p, int l, int g, int dir, float* lds) {
  const int TIDX = opq_v(threadIdx.x);
  float2* pw = (float2*)lds;
  float2* bb = pw + 33 * 64;
  float2* cm = bb + 1024;
  const int base = ((l * 2 + dir) * 16 + g);
  const float dt = expf(p.in(26)[base]);
  const int tid = TIDX;
  for (int e = tid; e < 33 * 64; e += 256) {
    int m = e >> 6, pp = e & 63;
    float ar = p.in(24)[base * 64 + pp], ai = p.in(25)[base * 64 + pp];
    float mag = expf(ar * dt * (float)m);
    float ang = ai * dt;
    double angm = (double)ang * (double)m;
    double tw = angm * 0.15915494309189535;
    tw -= floor(tw);
    float a = (float)(tw * 6.283185307179586);
    float sn, cs; sincosf(a, &sn, &cs);
    pw[e] = make_float2(mag * cs, mag * sn);
  }
  for (int e = tid; e < 1024; e += 256) {
    int pp = e >> 4, c = e & 15;
    float ar = p.in(24)[base * 64 + pp], ai = p.in(25)[base * 64 + pp];
    float mag = expf(ar * dt); float sn, cs; sincosf(ai * dt, &sn, &cs);
    float nr = mag * cs - 1.f, ni = mag * sn;
    float den = ar * ar + ai * ai;
    float qr = (nr * ar + ni * ai) / den, qi = (ni * ar - nr * ai) / den;
    float br = p.in(27)[(size_t)base * 1024 + e], bi = p.in(28)[(size_t)base * 1024 + e];
    bb[e] = make_float2(qr * br - qi * bi, qr * bi + qi * br);
    int c2 = e >> 6, p2 = e & 63;
    cm[e] = make_float2(p.in(29)[(size_t)base * 1024 + c2 * 64 + p2], p.in(30)[(size_t)base * 1024 + c2 * 64 + p2]);
  }
  __syncthreads();
  const int lg = l * 16 + g;
  u16* KK = (u16*)(p.ws() + OFF_S5KK) + ((size_t)lg * 2 + dir) * 8192;
  for (int e = tid; e < 8192; e += 256) {
    int m = e >> 8, c = (e >> 4) & 15, c2 = e & 15;
    float s = 0;
    for (int pp = 0; pp < 64; ++pp) {
      float2 C = cm[c * 64 + pp], W = pw[m * 64 + pp], B = bb[pp * 16 + c2];
      float tr = C.x * W.x - C.y * W.y, ti = C.x * W.y + C.y * W.x;
      s += tr * B.x - ti * B.y;
    }
    KK[e] = f2bf(s);
  }
  u16* E = (u16*)(p.ws() + OFF_S5E) + (size_t)lg * 256 * 512;
  for (int e = tid; e < 64 * 512; e += 256) {
    int pp = e >> 9, k = e & 511, j = k >> 4, c2 = k & 15;
    float2 W = pw[(dir == 0 ? 31 - j : j) * 64 + pp], B = bb[pp * 16 + c2];
    float vr = W.x * B.x - W.y * B.y, vi = W.x * B.y + W.y * B.x;
    E[(size_t)(dir * 128 + pp) * 512 + k] = f2bf(vr);
    E[(size_t)(dir * 128 + 64 + pp) * 512 + k] = f2bf(vi);
  }
  u16* G = (u16*)(p.ws() + OFF_S5G) + (size_t)lg * 512 * 256;
  for (int e = tid; e < 512 * 64; e += 256) {
    int row = e >> 6, pp = e & 63, i = row >> 4, c = row & 15;
    float2 C = cm[c * 64 + pp], W = pw[(dir == 0 ? i + 1 : 32 - i) * 64 + pp];
    float tr = C.x * W.x - C.y * W.y, ti = C.x * W.y + C.y * W.x;
    G[(size_t)row * 256 + dir * 128 + pp] = f2bf(tr);
    G[(size_t)row * 256 + dir * 128 + 64 + pp] = f2bf(-ti);
  }
  __syncthreads();
}

__device__ __forceinline__ void p0_cache(const Params& p, int item) {
  const int TIDX = opq_v(threadIdx.x);
  int l = item >> 4, b = (item >> 3) & 1, h = item & 7;
  const float* ck = p.in(2) + ((size_t)((b * 2 + l) * 8 + h)) * 16384;
  const float* cv = p.in(3) + ((size_t)((b * 2 + l) * 8 + h)) * 16384;
  u16* ok = (u16*)(p.ws() + OFF_CKB) + (size_t)item * 16384;
  u16* ov = (u16*)(p.ws() + OFF_CVT) + (size_t)item * 16384;
  for (int e = TIDX; e < 16384; e += 256) {
    ok[e] = f2bf(ck[e]);
    int d = e >> 8, key = e & 255;
    ov[e] = f2bf(cv[key * 64 + d]);
  }
}

__device__ __forceinline__ void phase0(const Params& p, float* lds) {
  const int TIDX = opq_v(threadIdx.x);
  const int BIDX = opq_s(blockIdx.x);
  const int N_FILT = 272, N_S5 = 64, N_MOD = 96, N_WIN = 1792, N_WOUT = 512, N_GLU = 32, N_CACHE = 32, N_ROPE = 1;
  const int total = N_FILT + N_S5 + N_MOD + N_WIN + N_WOUT + N_GLU + N_CACHE + N_ROPE;
  for (int it = BIDX; it < total; it += gridDim.x) {
    int i = it;
    if (i < N_FILT) {
      int l = i / 136, r = i % 136;
      if (r < 128) p0_filter(p, l, 1, r, lds); else p0_filter(p, l, 0, r - 128, lds);
      continue;
    }
    i -= N_FILT;
    if (i < N_S5) { p0_s5(p, i >> 5, (i >> 1) & 15, i & 1, lds); continue; }
    i -= N_S5;
    if (i < N_MOD) { p0_mod(p, i, lds); continue; }
    i -= N_MOD;
    if (i < N_WIN) {
      int l = i / 896, r = i % 896;
      p0_tr(p.in(11) + (size_t)l * 1024 * 3584, 3584, (u16*)(p.ws() + OFF_WINT) + (size_t)l * 3584 * 1024, 1024, (r / 56) * 64, (r % 56) * 64, lds);
      continue;
    }
    i -= N_WIN;
    if (i < N_WOUT) {
      int l = i >> 8, r = i & 255;
      p0_tr(p.in(12) + (size_t)l * 1024 * 1024, 1024, (u16*)(p.ws() + OFF_WOUTT) + (size_t)l * 1024 * 1024, 1024, (r >> 4) * 64, (r & 15) * 64, lds);
      continue;
    }
    i -= N_WOUT;
    if (i < N_GLU) {
      int l = i >> 4, r = i & 15;
      p0_tr(p.in(32) + (size_t)l * 65536, 256, (u16*)(p.ws() + OFF_GLUT) + (size_t)l * 65536, 256, (r >> 2) * 64, (r & 3) * 64, lds);
      continue;
    }
    i -= N_GLU;
    if (i < N_CACHE) { p0_cache(p, i); continue; }
    float2* tab = (float2*)(p.ws() + OFF_ROPE);
    for (int e = TIDX; e < 1024; e += 256) {
      int pos = e >> 4, k = e & 15;
      float inv = expf(-(float)k * (9.210340371976184f / 16.f));
      float sn, cs; sincosf((float)pos * inv, &sn, &cs);
      tab[e] = make_float2(cs, sn);
    }
  }
}

__device__ __forceinline__ void phase_prenorm(const Params& p, int l) {
  const int TIDX = opq_v(threadIdx.x);
  const int BIDX = opq_s(blockIdx.x);
  const float* mod = (const float*)(p.ws() + OFF_MOD) + l * 3 * 3072;
  const float* ng = p.in(8) + l * 1024;
  u16* hbf = (u16*)(p.ws() + OFF_HBF);
  int wave = TIDX >> 6, lane = TIDX & 63;
  for (int row = BIDX * 4 + wave; row < 16384; row += gridDim.x * 4) {
    const float* x = xrow(p, l, row);
    const float* md = mod + cond_of(row) * 3072;
    float4 v[4]; float ss = 0;
#pragma unroll
    for (int i = 0; i < 4; ++i) { v[i] = *(const float4*)(x + i * 256 + lane * 4); ss += v[i].x * v[i].x + v[i].y * v[i].y + v[i].z * v[i].z + v[i].w * v[i].w; }
    ss = warp_sum(ss);
    float rstd = rsqrtf(ss * (1.f / 1024.f) + 1e-6f);
#pragma unroll
    for (int i = 0; i < 4; ++i) {
      int col = i * 256 + lane * 4;
      float4 g = *(const float4*)(ng + col), sh = *(const float4*)(md + col), sc = *(const float4*)(md + 1024 + col);
      float h0 = v[i].x * rstd * g.x * (1.f + sc.x) + sh.x;
      float h1 = v[i].y * rstd * g.y * (1.f + sc.y) + sh.y;
      float h2 = v[i].z * rstd * g.z * (1.f + sc.z) + sh.z;
      float h3 = v[i].w * rstd * g.w * (1.f + sc.w) + sh.w;
      u32x2 o = {pack2(h0, h1), pack2(h2, h3)};
      *reinterpret_cast<u32x2*>(hbf + (size_t)row * 1024 + col) = o;
    }
  }
}

__device__ __forceinline__ void phase_finalnorm(const Params& p) {
  const int TIDX = opq_v(threadIdx.x);
  const int BIDX = opq_s(blockIdx.x);
  const float* ng = p.in(34);
  int wave = TIDX >> 6, lane = TIDX & 63;
  for (int row = BIDX * 4 + wave; row < 16384; row += gridDim.x * 4) {
    float* x = p.out() + (size_t)row * 1024;
    float4 v[4]; float ss = 0;
#pragma unroll
    for (int i = 0; i < 4; ++i) { v[i] = *(const float4*)(x + i * 256 + lane * 4); ss += v[i].x * v[i].x + v[i].y * v[i].y + v[i].z * v[i].z + v[i].w * v[i].w; }
    ss = warp_sum(ss);
    float rstd = rsqrtf(ss * (1.f / 1024.f) + 1e-6f);
#pragma unroll
    for (int i = 0; i < 4; ++i) {
      int col = i * 256 + lane * 4;
      float4 g = *(const float4*)(ng + col);
      float4 o = make_float4(v[i].x * rstd * g.x, v[i].y * rstd * g.y, v[i].z * rstd * g.z, v[i].w * rstd * g.w);
      *(float4*)(x + col) = o;
    }
  }
}

template <bool SWAP>
__device__ __forceinline__ void gemm_mainloop(const u16* __restrict__ A, const u16* __restrict__ Bt, int m0, int n0, char* smem, f32x4 (&acc)[4][4]) {
  const int tid = opq_v(threadIdx.x), lane = tid & 63, wid = tid >> 6, wm = wid >> 1, wn = wid & 1, fr = lane & 15, fq = lane >> 4;
  char* sA = smem; char* sB = smem + 16384;
  for (int kt = 0; kt < 16; ++kt) {
#pragma unroll
    for (int i = 0; i < 4; ++i) {
      int pch = i * 256 + tid; int r = pch >> 3, cp = pch & 7; int c = cp ^ ((r >> 1) & 7);
      __builtin_amdgcn_global_load_lds((const unsigned*)(A + (size_t)(m0 + r) * 1024 + kt * 64 + c * 8), (__attribute__((address_space(3))) unsigned*)(sA + pch * 16), 16, 0, 0);
      __builtin_amdgcn_global_load_lds((const unsigned*)(Bt + (size_t)(n0 + r) * 1024 + kt * 64 + c * 8), (__attribute__((address_space(3))) unsigned*)(sB + pch * 16), 16, 0, 0);
    }
    __syncthreads();
#pragma unroll
    for (int ks = 0; ks < 2; ++ks) {
      bf16x8 xa[4], wb[4];
#pragma unroll
      for (int t = 0; t < 4; ++t) {
        int c = ks * 4 + fq;
        int r = wm * 64 + t * 16 + fr;
        xa[t] = *(const bf16x8*)(sA + (r * 8 + (c ^ ((r >> 1) & 7))) * 16);
        int rn = wn * 64 + t * 16 + fr;
        wb[t] = *(const bf16x8*)(sB + (rn * 8 + (c ^ ((rn >> 1) & 7))) * 16);
      }
#pragma unroll
      for (int mt = 0; mt < 4; ++mt)
#pragma unroll
        for (int nt = 0; nt < 4; ++nt)
          acc[mt][nt] = SWAP ? mfma16(wb[nt], xa[mt], acc[mt][nt]) : mfma16(xa[mt], wb[nt], acc[mt][nt]);
    }
    __syncthreads();
  }
}

__device__ __forceinline__ void phase_gemm_in(const Params& p, int l, char* smem) {
  const int TIDX = opq_v(threadIdx.x);
  const int BIDX = opq_s(blockIdx.x);
  const u16* A = (const u16*)(p.ws() + OFF_HBF);
  const u16* Bt = (const u16*)(p.ws() + OFF_WINT) + (size_t)l * 3584 * 1024;
  u16* z = (u16*)(p.ws() + OFF_Z);
  u16* qrot = (u16*)(p.ws() + OFF_QROT);
  u16* vT = (u16*)(p.ws() + OFF_VT);
  const float2* tab = (const float2*)(p.ws() + OFF_ROPE);
  const int lane = TIDX & 63, wid = TIDX >> 6, wm = wid >> 1, wn = wid & 1, fr = lane & 15, fq = lane >> 4;
  for (int tile = BIDX; tile < 128 * 28; tile += gridDim.x) {
    int m0 = (tile / 28) * 128, n0 = (tile % 28) * 128;
    f32x4 acc[4][4];
#pragma unroll
    for (int a = 0; a < 4; ++a)
#pragma unroll
      for (int b = 0; b < 4; ++b) acc[a][b] = f32x4{0.f, 0.f, 0.f, 0.f};
    const bool vtile = n0 >= 1792 && n0 < 2304;
    if (vtile) {
      gemm_mainloop<false>(A, Bt, m0, n0, smem, acc);
#pragma unroll
      for (int mt = 0; mt < 4; ++mt)
#pragma unroll
        for (int nt = 0; nt < 4; ++nt) {
          int m = m0 + wm * 64 + mt * 16 + fq * 4, n = n0 + wn * 64 + nt * 16 + fr - 1792;
          f32x4 v = acc[mt][nt];
          u32x2 o = {pack2(v[0], v[1]), pack2(v[2], v[3])};
          *reinterpret_cast<u32x2*>(vT + (size_t)n * 16384 + m) = o;
          if (m0 < 8192) {
            int b = m >> 8, t = m & 255, head = n >> 6, d = n & 63;
            float* o2 = p.out() + OUT_V + ((size_t)((b * 2 + l) * 8 + head) * 256 + t) * 64 + d;
            o2[0] = v[0]; o2[64] = v[1]; o2[128] = v[2]; o2[192] = v[3];
          }
        }
    } else {
      gemm_mainloop<true>(A, Bt, m0, n0, smem, acc);
      const int nbase = n0 + wn * 64;
      const bool lat = m0 >= 8192;
      const bool isq = nbase >= 768 && nbase < 1280, isk = nbase >= 1280 && nbase < 1792;
#pragma unroll
      for (int mt = 0; mt < 4; ++mt) {
        int m = m0 + wm * 64 + mt * 16 + fr;
        if (!(lat && isk)) {
#pragma unroll
          for (int nt = 0; nt < 4; ++nt) {
            f32x4 v = acc[mt][nt];
            u32x2 o = {pack2(v[0], v[1]), pack2(v[2], v[3])};
            *reinterpret_cast<u32x2*>(z + (size_t)m * ZW + nbase + nt * 16 + fq * 4) = o;
          }
        }
        if (!lat && isk) {
          int b = m >> 8, t = m & 255, head = (nbase - 1280) >> 6;
          float* o2 = p.out() + OUT_K + ((size_t)((b * 2 + l) * 8 + head) * 256 + t) * 64 + fq * 4;
#pragma unroll
          for (int nt = 0; nt < 4; ++nt) *(float4*)(o2 + nt * 16) = make_float4(acc[mt][nt][0], acc[mt][nt][1], acc[mt][nt][2], acc[mt][nt][3]);
        }
        if (lat && (isq || isk)) {
          int ml = (m - 8192) & 4095; int prow = ml >> 6, pcol = ml & 63;
          f32x4 r[4];
#pragma unroll
          for (int j = 0; j < 4; ++j) {
            float2 a = tab[prow * 16 + fq * 4 + j], b = tab[pcol * 16 + fq * 4 + j];
            float x1 = acc[mt][0][j], x2 = acc[mt][1][j];
            r[0][j] = x1 * a.x - x2 * a.y; r[1][j] = x2 * a.x + x1 * a.y;
            x1 = acc[mt][2][j]; x2 = acc[mt][3][j];
            r[2][j] = x1 * b.x - x2 * b.y; r[3][j] = x2 * b.x + x1 * b.y;
          }
          u16* dst = isq ? qrot + (size_t)(m - 8192) * 512 + (nbase - 768) + fq * 4 : z + (size_t)m * ZW + nbase + fq * 4;
#pragma unroll
          for (int nt = 0; nt < 4; ++nt) {
            u32x2 o = {pack2(r[nt][0], r[nt][1]), pack2(r[nt][2], r[nt][3])};
            *reinterpret_cast<u32x2*>(dst + nt * 16) = o;
          }
        }
      }
    }
  }
}

__device__ __forceinline__ void phase_gemm_out(const Params& p, int l, char* smem) {
  const int TIDX = opq_v(threadIdx.x);
  const int BIDX = opq_s(blockIdx.x);
  const u16* A = (const u16*)(p.ws() + OFF_HBF);
  const u16* Bt = (const u16*)(p.ws() + OFF_WOUTT) + (size_t)l * 1024 * 1024;
  const float* mod = (const float*)(p.ws() + OFF_MOD) + l * 3 * 3072;
  const int lane = TIDX & 63, wid = TIDX >> 6, wm = wid >> 1, wn = wid & 1, fr = lane & 15, fq = lane >> 4;
  for (int tile = BIDX; tile < 128 * 8; tile += gridDim.x) {
    int m0 = (tile >> 3) * 128, n0 = (tile & 7) * 128;
    f32x4 acc[4][4];
#pragma unroll
    for (int a = 0; a < 4; ++a)
#pragma unroll
      for (int b = 0; b < 4; ++b) acc[a][b] = f32x4{0.f, 0.f, 0.f, 0.f};
    gemm_mainloop<true>(A, Bt, m0, n0, smem, acc);
#pragma unroll
    for (int mt = 0; mt < 4; ++mt) {
      int m = m0 + wm * 64 + mt * 16 + fr;
      const float* xr = xrow(p, l, m);
      const float* gate = mod + cond_of(m) * 3072 + 2048;
#pragma unroll
      for (int nt = 0; nt < 4; ++nt) {
        int n = n0 + wn * 64 + nt * 16 + fq * 4;
        float4 x = *(const float4*)(xr + n), g = *(const float4*)(gate + n);
        f32x4 v = acc[mt][nt];
        *(float4*)(p.out() + (size_t)m * 1024 + n) = make_float4(x.x + g.x * v[0], x.y + g.y * v[1], x.z + g.z * v[2], x.w + g.w * v[3]);
      }
    }
  }
}

struct AttState { float m, l; f32x16 o0, o1; };

__device__ __forceinline__ void attn_tile(const f32x16& s, AttState& st, const u16* vt, size_t vstride, int lane) {
  float mx = s[0];
#pragma unroll
  for (int i = 1; i < 16; ++i) mx = fmaxf(mx, s[i]);
  mx = fmaxf(mx, __shfl_xor(mx, 32));
  float mn = fmaxf(st.m, mx);
  float alpha = __expf(st.m - mn);
  float pv[16]; float ps = 0;
#pragma unroll
  for (int i = 0; i < 16; ++i) { pv[i] = __expf(s[i] - mn); ps += pv[i]; }
  st.l = st.l * alpha + ps; st.m = mn;
#pragma unroll
  for (int i = 0; i < 16; ++i) { st.o0[i] *= alpha; st.o1[i] *= alpha; }
  const int d = lane & 31, h = lane >> 5;
#pragma unroll
  for (int sp = 0; sp < 2; ++sp) {
    u32x4 pw = {pack2(pv[8 * sp], pv[8 * sp + 1]), pack2(pv[8 * sp + 2], pv[8 * sp + 3]), pack2(pv[8 * sp + 4], pv[8 * sp + 5]), pack2(pv[8 * sp + 6], pv[8 * sp + 7])};
    bf16x8 pf = __builtin_bit_cast(bf16x8, pw);
    const u16* v0 = vt + (size_t)d * vstride + 16 * sp + 4 * h;
    u32x2 a0 = *reinterpret_cast<const u32x2*>(v0), a1 = *reinterpret_cast<const u32x2*>(v0 + 8);
    u32x4 va = {a0[0], a0[1], a1[0], a1[1]};
    st.o0 = mfma32(__builtin_bit_cast(bf16x8, va), pf, st.o0);
    const u16* v1 = v0 + 32 * vstride;
    u32x2 b0 = *reinterpret_cast<const u32x2*>(v1), b1 = *reinterpret_cast<const u32x2*>(v1 + 8);
    u32x4 vb = {b0[0], b0[1], b1[0], b1[1]};
    st.o1 = mfma32(__builtin_bit_cast(bf16x8, vb), pf, st.o1);
  }
}

__device__ __forceinline__ void attn_finish(AttState& st, const u16* z, u16* ybf, int tok, int head, int lane) {
  float lt = st.l + __shfl_xor(st.l, 32);
  float inv = 1.f / lt;
  const int h = lane >> 5;
#pragma unroll
  for (int dt = 0; dt < 2; ++dt)
#pragma unroll
    for (int rg = 0; rg < 4; ++rg) {
      int d0 = dt * 32 + 8 * rg + 4 * h;
      u32x2 gg = *reinterpret_cast<const u32x2*>(z + (size_t)tok * ZW + 2560 + 256 + head * 64 + d0);
      float o[4];
#pragma unroll
      for (int i = 0; i < 4; ++i) o[i] = (dt ? st.o1[4 * rg + i] : st.o0[4 * rg + i]) * inv;
      o[0] *= silu_f(bfl(gg[0])); o[1] *= silu_f(bfh(gg[0])); o[2] *= silu_f(bfl(gg[1])); o[3] *= silu_f(bfh(gg[1]));
      u32x2 ov = {pack2(o[0], o[1]), pack2(o[2], o[3])};
      *reinterpret_cast<u32x2*>(ybf + (size_t)tok * 1024 + 256 + head * 64 + d0) = ov;
    }
}

__device__ __forceinline__ void attn_ctx_item(const Params& p, int item) {
  const int TIDX = opq_v(threadIdx.x);
  const int b = item >> 3, head = item & 7;
  const u16* z = (const u16*)(p.ws() + OFF_Z);
  const u16* vT = (const u16*)(p.ws() + OFF_VT);
  u16* ybf = (u16*)(p.ws() + OFF_HBF);
  const int lane = TIDX & 63, wid = TIDX >> 6, r = lane & 31, h = lane >> 5;
  const int tok0 = b * 256;
  for (int pass = 0; pass < 2; ++pass) {
    const int qt = wid + 4 * pass;
    const int qtok = tok0 + qt * 32 + r;
    bf16x8 qf[4];
#pragma unroll
    for (int ks = 0; ks < 4; ++ks) qf[ks] = ld16(z + (size_t)qtok * ZW + 768 + head * 64 + ks * 16 + 8 * h);
    AttState st; st.m = -1e30f; st.l = 0.f;
#pragma unroll
    for (int i = 0; i < 16; ++i) { st.o0[i] = 0.f; st.o1[i] = 0.f; }
    for (int kt = 0; kt < 8; ++kt) {
      f32x16 s;
#pragma unroll
      for (int i = 0; i < 16; ++i) s[i] = 0.f;
      const u16* kp = z + (size_t)(tok0 + kt * 32 + r) * ZW + 1280 + head * 64 + 8 * h;
#pragma unroll
      for (int ks = 0; ks < 4; ++ks) s = mfma32(ld16(kp + ks * 16), qf[ks], s);
#pragma unroll
      for (int i = 0; i < 16; ++i) s[i] *= 0.125f;
      attn_tile(s, st, vT + (size_t)(head * 64) * 16384 + tok0 + kt * 32, 16384, lane);
    }
    attn_finish(st, z, ybf, qtok, head, lane);
  }
}

__device__ __forceinline__ void attn_lat_item(const Params& p, int l, int item) {
  const int TIDX = opq_v(threadIdx.x);
  const int b = item >> 8, head = (item >> 5) & 7, rp = item & 31;
  const u16* z = (const u16*)(p.ws() + OFF_Z);
  const u16* vT = (const u16*)(p.ws() + OFF_VT);
  const u16* qrot = (const u16*)(p.ws() + OFF_QROT);
  u16* ybf = (u16*)(p.ws() + OFF_HBF);
  const int lane = TIDX & 63, wid = TIDX >> 6, r = lane & 31, h = lane >> 5;
  const int grow = rp * 2 + (wid >> 1), qt = wid & 1;
  const int qc = qt * 32 + r;
  const int ltok = b * 4096 + grow * 64 + qc;
  const int qtok = 8192 + ltok;
  AttState st; st.m = -1e30f; st.l = 0.f;
#pragma unroll
  for (int i = 0; i < 16; ++i) { st.o0[i] = 0.f; st.o1[i] = 0.f; }
  {
    bf16x8 qf[4];
#pragma unroll
    for (int ks = 0; ks < 4; ++ks) qf[ks] = ld16(z + (size_t)qtok * ZW + 768 + head * 64 + ks * 16 + 8 * h);
    const u16* ck = (const u16*)(p.ws() + OFF_CKB) + (size_t)((l * 2 + b) * 8 + head) * 16384;
    const u16* cv = (const u16*)(p.ws() + OFF_CVT) + (size_t)((l * 2 + b) * 8 + head) * 16384;
    for (int kt = 0; kt < 8; ++kt) {
      f32x16 s;
#pragma unroll
      for (int i = 0; i < 16; ++i) s[i] = 0.f;
      const u16* kp = ck + (size_t)(kt * 32 + r) * 64 + 8 * h;
#pragma unroll
      for (int ks = 0; ks < 4; ++ks) s = mfma32(ld16(kp + ks * 16), qf[ks], s);
#pragma unroll
      for (int i = 0; i < 16; ++i) s[i] *= 0.125f;
      attn_tile(s, st, cv + kt * 32, 256, lane);
    }
  }
  {
    bf16x8 qf[4];
#pragma unroll
    for (int ks = 0; ks < 4; ++ks) qf[ks] = ld16(qrot + (size_t)ltok * 512 + head * 64 + ks * 16 + 8 * h);
    const float* rpb = p.in(23) + (size_t)(l * 8 + head) * 15 * 31;
    int rs = grow - 4; rs = rs < 0 ? 0 : (rs > 56 ? 56 : rs);
    int cstart = qc - 8; cstart = cstart < 0 ? 0 : (cstart > 48 ? 48 : cstart);
    for (int wi = 0; wi < 8; ++wi) {
      const int kr = rs + wi;
      const float* rb = rpb + (kr - grow + 7) * 31;
      for (int hf = 0; hf < 2; ++hf) {
        const int ktok = 8192 + b * 4096 + kr * 64 + hf * 32;
        f32x16 s;
#pragma unroll
        for (int i = 0; i < 16; ++i) s[i] = 0.f;
        const u16* kp = z + (size_t)(ktok + r) * ZW + 1280 + head * 64 + 8 * h;
#pragma unroll
        for (int ks = 0; ks < 4; ++ks) s = mfma32(ld16(kp + ks * 16), qf[ks], s);
#pragma unroll
        for (int i = 0; i < 16; ++i) {
          int kc = hf * 32 + (i & 3) + 8 * (i >> 2) + 4 * h;
          bool valid = kc >= cstart && kc < cstart + 16;
          int ci = kc - qc + 15; ci = ci < 0 ? 0 : (ci > 30 ? 30 : ci);
          float bias = rb[ci];
          s[i] = valid ? s[i] * 0.125f + bias : -INFINITY;
        }
        attn_tile(s, st, vT + (size_t)(head * 64) * 16384 + ktok, 16384, lane);
      }
    }
  }
  attn_finish(st, z, ybf, qtok, head, lane);
}

__device__ __forceinline__ float hy_zc(const u16* zcol, int t, int L, float w0, float w1, float w2, float bias) {
  float a = bias + w1 * bf2f(zcol[(size_t)t * ZW]);
  if (t > 0) a += w0 * bf2f(zcol[(size_t)(t - 1) * ZW]);
  if (t < L - 1) a += w2 * bf2f(zcol[(size_t)(t + 1) * ZW]);
  return a;
}

__device__ __forceinline__ void hyena_lat_item(const Params& p, int l, int ch, char* smem) {
  const int TIDX = opq_v(threadIdx.x);
  u16* Hs = (u16*)smem;
  u16* UR = (u16*)(smem + 18432);
  float* red = (float*)(smem + 18432 + 16960);
  const u16* z = (const u16*)(p.ws() + OFF_Z);
  u16* ybf = (u16*)(p.ws() + OFF_HBF);
  const u16* taps = (const u16*)(p.ws() + OFF_TAPS + l * TAPS_LAYER);
  const float* psum = (const float*)(p.ws() + OFF_PSUM + l * PSUM_LAYER);
  const float* cw = p.in(13) + l * 3 * 768; const float* cb = p.in(14) + l * 768;
  const int tid = TIDX, lane = tid & 63, wid = tid >> 6;
  {
    int o = tid >> 7, idx = tid & 127;
    float s = psum[idx * 1024 + o * 512 + ch] + psum[idx * 1024 + o * 512 + 256 + ch];
    s = warp_sum(s);
    if (lane == 0) red[wid] = s;
  }
  {
    float w0 = cw[ch], w1 = cw[768 + ch], w2 = cw[1536 + ch], bs = cb[ch];
    for (int e = tid; e < 2 * 4240; e += 256) {
      int b = e / 4240, i = e % 4240; int t = 4159 - i;
      float v = 0.f;
      if (t >= 0 && t < 4096) v = hy_zc(z + (size_t)(8192 + b * 4096) * ZW + ch, t, 4096, w0, w1, w2, bs);
      UR[e] = f2bf(v);
    }
  }
  __syncthreads();
  const int bsel = wid >> 1, chalf = wid & 1;
  const int r = lane & 31, g = lane >> 5;
  const int c = chalf * 32 + r;
  for (int o = 0; o < 2; ++o) {
    const float inv = 1.f / (red[o * 2] + red[o * 2 + 1]);
    const u16* tf = taps + (size_t)(o * 512 + ch) * 4096;
    const u16* tb = taps + (size_t)(o * 512 + 256 + ch) * 4096;
    for (int i = tid; i < 8192; i += 256) {
      float v = 0.f;
      if (i >= 4096) v = bf2f(tf[i - 4096]); else if (i > 0) v = bf2f(tb[4096 - i]);
      Hs[i + 8 * (i >> 6)] = f2bf(v * inv);
    }
    __syncthreads();
    f32x16 acc0, acc1;
#pragma unroll
    for (int i = 0; i < 16; ++i) { acc0[i] = 0.f; acc1[i] = 0.f; }
    {
      const int start0 = 63 - c + 8 * g;
      const unsigned sh = (start0 & 1) * 16;
      const unsigned* bp = (const unsigned*)(UR + bsel * 4240 + (start0 & ~1));
      for (int ks = 0; ks < 260; ++ks) {
        const unsigned* q = bp + ks * 8;
        unsigned d0 = q[0], d1 = q[1], d2 = q[2], d3 = q[3], d4 = q[4];
        u32x4 bw = {__builtin_amdgcn_alignbit(d1, d0, sh), __builtin_amdgcn_alignbit(d2, d1, sh), __builtin_amdgcn_alignbit(d3, d2, sh), __builtin_amdgcn_alignbit(d4, d3, sh)};
        bf16x8 bf = __builtin_bit_cast(bf16x8, bw);
        int x = 16 * ks + 8 * g;
        int pos0 = 72 * (r + (x >> 6)) + (x & 63);
        bf16x8 a0 = ld16(Hs + pos0);
        bf16x8 a1 = ld16(Hs + pos0 + 72 * 32);
        acc0 = mfma32(a0, bf, acc0);
        acc1 = mfma32(a1, bf, acc1);
      }
    }
    const int gcol = o == 0 ? 256 + ch : 512 + ch;
    const float w0 = cw[gcol], w1 = cw[768 + gcol], w2 = cw[1536 + gcol], bs = cb[gcol];
    const float hb = p.in(22)[(l * 2 + o) * 256 + ch];
    const u16* zg = z + (size_t)(8192 + bsel * 4096) * ZW + gcol;
#pragma unroll
    for (int i0 = 0; i0 < 32; i0 += 4) {
#pragma unroll
      for (int ii = 0; ii < 4; ++ii) {
        const int i = i0 + ii;
        int row = (i & 3) + 8 * ((i & 15) >> 2) + 4 * g + 32 * (i >> 4);
        int t = 64 * row + c;
        asm volatile("" : "+v"(t));
        float conv = i < 16 ? acc0[i & 15] : acc1[i & 15];
        float uv = bf2f(UR[bsel * 4240 + 4159 - t]);
        float xg = hy_zc(zg, t, 4096, w0, w1, w2, bs);
        float rv = xg * (conv + hb * uv);
        if (o == 1) {
          size_t tok = 8192 + bsel * 4096 + t;
          float gv = bf2f(z[tok * ZW + 2560 + ch]);
          ybf[tok * 1024 + ch] = f2bf(rv * silu_f(gv));
        }
        if (i < 16) acc0[i & 15] = rv; else acc1[i & 15] = rv;
      }
      __builtin_amdgcn_sched_barrier(0);
    }
    __syncthreads();
    if (o == 0) {
#pragma unroll
      for (int i = 0; i < 32; ++i) {
        int row = (i & 3) + 8 * ((i & 15) >> 2) + 4 * g + 32 * (i >> 4);
        int t = 64 * row + c;
        UR[bsel * 4240 + 4159 - t] = f2bf(i < 16 ? acc0[i & 15] : acc1[i & 15]);
      }
    }
    __syncthreads();
  }
}

__device__ __forceinline__ void hyena_ctx_item(const Params& p, int l, int item, char* smem) {
  const int TIDX = opq_v(threadIdx.x);
  const int b = item >> 6, cg4 = item & 63;
  const int tid = TIDX, lane = tid & 63, wid = tid >> 6;
  const int ch = cg4 * 4 + wid;
  float* Hs = (float*)smem + wid * 1024;
  float* U = Hs + 512;
  const u16* z = (const u16*)(p.ws() + OFF_Z);
  u16* ybf = (u16*)(p.ws() + OFF_HBF);
  const u16* taps = (const u16*)(p.ws() + OFF_TAPS + l * TAPS_LAYER + 8388608);
  const float* psum = (const float*)(p.ws() + OFF_PSUM + l * PSUM_LAYER) + 128 * 1024;
  const float* cw = p.in(13) + l * 3 * 768; const float* cb = p.in(14) + l * 768;
  const u16* zs = z + (size_t)(b * 256) * ZW;
  float vv[4];
  {
    float w0 = cw[ch], w1 = cw[768 + ch], w2 = cw[1536 + ch], bs = cb[ch];
#pragma unroll
    for (int i = 0; i < 4; ++i) { int t = lane + 64 * i; vv[i] = hy_zc(zs + ch, t, 256, w0, w1, w2, bs); U[t] = vv[i]; }
  }
  for (int o = 0; o < 2; ++o) {
    float s = 0.f;
    if (lane < 16) s = psum[(lane & 7) * 1024 + o * 512 + (lane >> 3) * 256 + ch];
    s = warp_sum(s);
    const float inv = 1.f / s;
    const u16* tf = taps + (size_t)(o * 512 + ch) * 256;
    const u16* tb = taps + (size_t)(o * 512 + 256 + ch) * 256;
    for (int idx = lane; idx < 512; idx += 64) {
      int off = idx - 255; float v = 0.f;
      if (idx < 511) v = off >= 0 ? bf2f(tf[off]) : bf2f(tb[-off]);
      Hs[idx] = v * inv;
    }
    __syncthreads();
    float acc[4] = {0.f, 0.f, 0.f, 0.f};
    for (int sidx = 0; sidx < 256; ++sidx) {
      float uu = U[sidx];
#pragma unroll
      for (int i = 0; i < 4; ++i) acc[i] += Hs[lane + 64 * i - sidx + 255] * uu;
    }
    const int gcol = o == 0 ? 256 + ch : 512 + ch;
    const float w0 = cw[gcol], w1 = cw[768 + gcol], w2 = cw[1536 + gcol], bs = cb[gcol];
    const float hb = p.in(22)[(l * 2 + o) * 256 + ch];
    float res[4];
#pragma unroll
    for (int i = 0; i < 4; ++i) {
      int t = lane + 64 * i;
      float xg = hy_zc(zs + gcol, t, 256, w0, w1, w2, bs);
      res[i] = xg * (acc[i] + hb * vv[i]);
    }
    __syncthreads();
    if (o == 0) {
#pragma unroll
      for (int i = 0; i < 4; ++i) { U[lane + 64 * i] = res[i]; vv[i] = res[i]; }
    } else {
#pragma unroll
      for (int i = 0; i < 4; ++i) {
        size_t tok = b * 256 + lane + 64 * i;
        float gv = bf2f(z[tok * ZW + 2560 + ch]);
        ybf[tok * 1024 + ch] = f2bf(res[i] * silu_f(gv));
      }
    }
    __syncthreads();
  }
}

__device__ __forceinline__ int s5_tokbase(int ss, int col) {
  if (ss < 2) return 8192 + ss * 4096 + 32 * col;
  return (16 * (ss - 2) + (col >> 3)) * 256 + 32 * (col & 7);
}

__device__ __forceinline__ void s5_item(const Params& p, int l, int item) {
  const int TIDX = opq_v(threadIdx.x);
  const int g = item >> 2, ss = item & 3;
  const int lg = l * 16 + g;
  const u16* z = (const u16*)(p.ws() + OFF_Z);
  const u16* E = (const u16*)(p.ws() + OFF_S5E) + (size_t)lg * 256 * 512;
  const u16* G = (const u16*)(p.ws() + OFF_S5G) + (size_t)lg * 512 * 256;
  const u16* KK = (const u16*)(p.ws() + OFF_S5KK) + (size_t)lg * 2 * 8192;
  float* Eu = (float*)(p.ws() + OFF_EU) + (size_t)item * 256 * 128;
  u16* Sin = (u16*)(p.ws() + OFF_SIN) + (size_t)item * 128 * 256;
  u16* yg = (u16*)(p.ws() + OFF_YG);
  const int tid = TIDX, lane = tid & 63, wid = tid >> 6, r = lane & 31, h = lane >> 5;
  const int col = wid * 32 + r;
  const int tb = s5_tokbase(ss, col);
  const u16* ub = z + (size_t)tb * ZW + 2304 + g * 16 + 8 * h;
  for (int half = 0; half < 2; ++half) {
    f32x16 acc[4];
#pragma unroll
    for (int a = 0; a < 4; ++a)
#pragma unroll
      for (int i = 0; i < 16; ++i) acc[a][i] = 0.f;
    for (int j = 0; j < 32; ++j) {
      bf16x8 uf = ld16(ub + (size_t)j * ZW);
#pragma unroll
      for (int rt = 0; rt < 4; ++rt) {
        bf16x8 ef = ld16(E + (size_t)(half * 128 + rt * 32 + r) * 512 + j * 16 + 8 * h);
        acc[rt] = mfma32(ef, uf, acc[rt]);
      }
    }
#pragma unroll
    for (int rt = 0; rt < 4; ++rt)
#pragma unroll
      for (int i = 0; i < 16; ++i) {
        int row = half * 128 + rt * 32 + (i & 3) + 8 * (i >> 2) + 4 * h;
        Eu[row * 128 + col] = acc[rt][i];
      }
  }
  __syncthreads();
  if (ss < 2) {
    if (tid < 128) {
      int dir = tid >> 6, pp = tid & 63;
      int base = (l * 2 + dir) * 16 + g;
      float dt = expf(p.in(26)[base]);
      float ar = p.in(24)[base * 64 + pp], ai = p.in(25)[base * 64 + pp];
      float mag = expf(ar * dt * 32.f);
      double tw = (double)(ai * dt) * 32.0 * 0.15915494309189535; tw -= floor(tw);
      float sn, cs; sincosf((float)(tw * 6.283185307179586), &sn, &cs);
      float lr = mag * cs, li = mag * sn;
      size_t sidx = ((size_t)((ss * 2 + l) * 2 + dir) * 16 + g) * 64 + pp;
      float sr = p.in(4)[sidx], si = p.in(5)[sidx];
      const float* er = Eu + (dir * 128 + pp) * 128; const float* ei = er + 64 * 128;
      for (int cc = 0; cc < 128; ++cc) {
        int c2 = dir == 0 ? cc : 127 - cc;
        Sin[c2 * 256 + dir * 128 + pp] = f2bf(sr); Sin[c2 * 256 + dir * 128 + 64 + pp] = f2bf(si);
        float nr = lr * sr - li * si + er[c2], ni = lr * si + li * sr + ei[c2];
        sr = nr; si = ni;
      }
    }
  } else {
    for (int e = tid; e < 2048; e += 256) {
      int sq = e >> 7, dir = (e >> 6) & 1, pp = e & 63;
      int base = (l * 2 + dir) * 16 + g;
      float dt = expf(p.in(26)[base]);
      float ar = p.in(24)[base * 64 + pp], ai = p.in(25)[base * 64 + pp];
      float mag = expf(ar * dt * 32.f);
      double tw = (double)(ai * dt) * 32.0 * 0.15915494309189535; tw -= floor(tw);
      float sn, cs; sincosf((float)(tw * 6.283185307179586), &sn, &cs);
      float lr = mag * cs, li = mag * sn;
      float sr = 0.f, si = 0.f;
      const float* er = Eu + (dir * 128 + pp) * 128; const float* ei = er + 64 * 128;
      for (int cc = 0; cc < 8; ++cc) {
        int c2 = sq * 8 + (dir == 0 ? cc : 7 - cc);
        Sin[c2 * 256 + dir * 128 + pp] = f2bf(sr); Sin[c2 * 256 + dir * 128 + 64 + pp] = f2bf(si);
        float nr = lr * sr - li * si + er[c2], ni = lr * si + li * sr + ei[c2];
        sr = nr; si = ni;
      }
      int bq = 16 * (ss - 2) + sq;
      size_t oidx = ((size_t)((bq * 2 + l) * 2 + dir) * 16 + g) * 64 + pp;
      p.out()[OUT_SRE + oidx] = sr; p.out()[OUT_SIM + oidx] = si;
    }
  }
  __syncthreads();
  const float* dsk = p.in(31) + l * 256 + g * 16;
  for (int rg = 0; rg < 4; ++rg) {
    f32x16 acc[4];
#pragma unroll
    for (int a = 0; a < 4; ++a)
#pragma unroll
      for (int i = 0; i < 16; ++i) acc[a][i] = 0.f;
    for (int j = 0; j < 32; ++j) {
      bf16x8 uf = ld16(ub + (size_t)j * ZW);
#pragma unroll
      for (int rt = 0; rt < 4; ++rt) {
        int i = 2 * (rg * 4 + rt) + (r >> 4), c = r & 15;
        int m = i - j;
        if (j <= 2 * (rg * 4 + rt) + 1) {
          bf16x8 f = zero8();
          if (m >= 0) f = ld16(KK + (size_t)m * 256 + c * 16 + 8 * h);
          acc[rt] = mfma32(f, uf, acc[rt]);
        }
        if (j >= 2 * (rg * 4 + rt)) {
          bf16x8 f = zero8();
          if (m <= 0) f = ld16(KK + 8192 + (size_t)(-m) * 256 + c * 16 + 8 * h);
          acc[rt] = mfma32(f, uf, acc[rt]);
        }
      }
    }
    for (int ks = 0; ks < 16; ++ks) {
      bf16x8 sf = ld16(Sin + (size_t)col * 256 + ks * 16 + 8 * h);
#pragma unroll
      for (int rt = 0; rt < 4; ++rt) {
        bf16x8 gf = ld16(G + (size_t)((rg * 4 + rt) * 32 + r) * 256 + ks * 16 + 8 * h);
        acc[rt] = mfma32(gf, sf, acc[rt]);
      }
    }
#pragma unroll
    for (int rt = 0; rt < 4; ++rt)
#pragma unroll
      for (int q = 0; q < 4; ++q) {
        int i = 2 * (rg * 4 + rt) + (q >> 1);
        int c0 = 8 * (q & 1) + 4 * h;
        size_t tok = tb + i;
        u32x2 uu = *reinterpret_cast<const u32x2*>(z + tok * ZW + 2304 + g * 16 + c0);
        float uvals[4] = {bfl(uu[0]), bfh(uu[0]), bfl(uu[1]), bfh(uu[1])};
        float o[4];
#pragma unroll
        for (int e = 0; e < 4; ++e) {
          float y = acc[rt][4 * q + e] + dsk[c0 + e] * uvals[e];
          float t3 = 0.7978845608028654f * (y + 0.044715f * y * y * y);
          o[e] = 0.5f * y * (1.f + tanhf(t3));
        }
        u32x2 ov = {pack2(o[0], o[1]), pack2(o[2], o[3])};
        *reinterpret_cast<u32x2*>(yg + tok * 256 + g * 16 + c0) = ov;
      }
  }
  __syncthreads();
}

__device__ __forceinline__ void glu_item(const Params& p, int l, int item) {
  const int TIDX = opq_v(threadIdx.x);
  const u16* yg = (const u16*)(p.ws() + OFF_YG);
  const u16* gT = (const u16*)(p.ws() + OFF_GLUT) + (size_t)l * 65536;
  const u16* z = (const u16*)(p.ws() + OFF_Z);
  u16* ybf = (u16*)(p.ws() + OFF_HBF);
  const float* gb = p.in(33) + l * 256;
  const int lane = TIDX & 63, wid = TIDX >> 6, r = lane & 31, h = lane >> 5;
  const int tok = item * 32 + r;
  f32x16 acc[2];
#pragma unroll
  for (int a = 0; a < 2; ++a)
#pragma unroll
    for (int i = 0; i < 16; ++i) acc[a][i] = 0.f;
  for (int ks = 0; ks < 16; ++ks) {
    bf16x8 yf = ld16(yg + (size_t)tok * 256 + ks * 16 + 8 * h);
#pragma unroll
    for (int rt = 0; rt < 2; ++rt) {
      bf16x8 wf = ld16(gT + (size_t)(wid * 64 + rt * 32 + r) * 256 + ks * 16 + 8 * h);
      acc[rt] = mfma32(wf, yf, acc[rt]);
    }
  }
#pragma unroll
  for (int rt = 0; rt < 2; ++rt)
#pragma unroll
    for (int q = 0; q < 4; ++q) {
      int n0 = wid * 64 + rt * 32 + 8 * q + 4 * h;
      u32x2 yy = *reinterpret_cast<const u32x2*>(yg + (size_t)tok * 256 + n0);
      u32x2 gg = *reinterpret_cast<const u32x2*>(z + (size_t)tok * ZW + 2560 + 768 + n0);
      float yv[4] = {bfl(yy[0]), bfh(yy[0]), bfl(yy[1]), bfh(yy[1])};
      float gv[4] = {bfl(gg[0]), bfh(gg[0]), bfl(gg[1]), bfh(gg[1])};
      float o[4];
#pragma unroll
      for (int e = 0; e < 4; ++e) {
        float v = acc[rt][4 * q + e] + gb[n0 + e];
        o[e] = yv[e] / (1.f + __expf(-v)) * silu_f(gv[e]);
      }
      u32x2 ov = {pack2(o[0], o[1]), pack2(o[2], o[3])};
      *reinterpret_cast<u32x2*>(ybf + (size_t)tok * 1024 + 768 + n0) = ov;
    }
}

__device__ __forceinline__ void phase_mixers(const Params& p, int l, char* smem) {
  const int BIDX = opq_s(blockIdx.x);
  const int N_HL = 256, N_S5 = 64, N_AL = 512, N_AC = 256, N_HC = 2048;
  const int total = N_HL + N_S5 + N_AL + N_AC + N_HC;
  for (int it = BIDX; it < total; it += gridDim.x) {
    int i = it;
    if (i < N_HL) { hyena_lat_item(p, l, i, smem); continue; }
    i -= N_HL;
    if (i < N_S5) { s5_item(p, l, i); continue; }
    i -= N_S5;
    if (i < N_AL) { attn_lat_item(p, l, i); continue; }
    i -= N_AL;
    if (i < N_AC) { attn_ctx_item(p, i); continue; }
    i -= N_AC;
    hyena_ctx_item(p, l, i, smem);
  }
}

__global__ void __launch_bounds__(256, 2) fwd_megakernel(KArgs ka) {
  __shared__ __attribute__((aligned(16))) char smem[LDS_BYTES + 512];
  cg::grid_group grid = cg::this_grid();
  {
    unsigned long long* t = (unsigned long long*)(smem + LDS_BYTES);
    if (threadIdx.x == 0) {
#pragma unroll
      for (int i = 0; i < 35; ++i) t[i] = (unsigned long long)ka.in[i];
      t[35] = (unsigned long long)ka.out; t[36] = (unsigned long long)ka.ws;
    }
    __syncthreads();
  }
  Params p; p.tab = (const unsigned long long*)(smem + LDS_BYTES);
  phase0(p, (float*)smem);
  grid.sync();
#pragma unroll 1
  for (int l0 = 0; l0 < 2; ++l0) {
    const int l = opq_s(l0);
    phase_prenorm(p, l);
    grid.sync();
    phase_gemm_in(p, l, smem);
    grid.sync();
    phase_mixers(p, l, smem);
    grid.sync();
    for (int it = blockIdx.x; it < 512; it += gridDim.x) glu_item(p, l, it);
    grid.sync();
    phase_gemm_out(p, l, smem);
    grid.sync();
  }
  phase_finalnorm(p);
}

extern "C" void kernel_launch(void* const* d_in, const int* in_sizes, int n_in, void* d_out, int out_size, void* d_ws, size_t ws_size, hipStream_t stream) {
  static int grid_blocks = 0;
  if (!grid_blocks) {
    int dev = 0, cus = 0, per_cu = 0;
    hipGetDevice(&dev);
    hipDeviceGetAttribute(&cus, hipDeviceAttributeMultiprocessorCount, dev);
    hipOccupancyMaxActiveBlocksPerMultiprocessor(&per_cu, fwd_megakernel, 256, 0);
    if (per_cu > 4) per_cu = 4;
    grid_blocks = cus * per_cu;
  }
  KArgs p{};
  for (int i = 0; i < 35; ++i) p.in[i] = (const float*)d_in[i];
  p.out = (float*)d_out;
  p.ws = (char*)d_ws;
  void* args[] = {&p};
  hipError_t e = hipLaunchCooperativeKernel((void*)fwd_megakernel, dim3(grid_blocks), dim3(256), args, 0, stream);
  if (e != hipSuccess) fprintf(stderr, "cooperative launch failed: %s (grid %d)\n", hipGetErrorString(e), grid_blocks);
}
```

```cpp
#include <hip/hip_runtime.h>
#include <hip/hip_cooperative_groups.h>
#include <cstdio>
namespace cg = cooperative_groups;

typedef unsigned short u16;
using bf16x8 = __attribute__((ext_vector_type(8))) short;
using f32x4 = __attribute__((ext_vector_type(4))) float;
using f32x16 = __attribute__((ext_vector_type(16))) float;
using u32x4 = __attribute__((ext_vector_type(4))) unsigned;
using u32x2 = __attribute__((ext_vector_type(2))) unsigned;

struct KArgs { const float* in[35]; float* out; char* ws; };
struct Params {
  const unsigned long long* tab;
  __device__ __forceinline__ unsigned long long get(int i) const {
    unsigned long long v = tab[i];
    unsigned lo = __builtin_amdgcn_readfirstlane((unsigned)v), hi = __builtin_amdgcn_readfirstlane((unsigned)(v >> 32));
    return ((unsigned long long)hi << 32) | lo;
  }
  __device__ __forceinline__ const float* in(int i) const { return (const float*)get(i); }
  __device__ __forceinline__ float* out() const { return (float*)get(35); }
  __device__ __forceinline__ char* ws() const { return (char*)get(36); }
};

constexpr size_t OFF_MOD   = 0;
constexpr size_t OFF_WINT  = OFF_MOD   + 73728;
constexpr size_t OFF_WOUTT = OFF_WINT  + 14680064;
constexpr size_t OFF_GLUT  = OFF_WOUTT + 4194304;
constexpr size_t OFF_HBF   = OFF_GLUT  + 262144;
constexpr size_t OFF_Z     = OFF_HBF   + 33554432;
constexpr size_t OFF_QROT  = OFF_Z     + 117440512;
constexpr size_t OFF_VT    = OFF_QROT  + 8388608;
constexpr size_t OFF_TAPS  = OFF_VT    + 16777216;
constexpr size_t TAPS_LAYER = 8388608 + 524288;
constexpr size_t OFF_PSUM  = OFF_TAPS  + 2 * TAPS_LAYER;
constexpr size_t PSUM_LAYER = (128 + 8) * 1024 * 4;
constexpr size_t OFF_CKB   = OFF_PSUM  + 2 * PSUM_LAYER;
constexpr size_t OFF_CVT   = OFF_CKB   + 1048576;
constexpr size_t OFF_ROPE  = OFF_CVT   + 1048576;
constexpr size_t OFF_S5KK  = OFF_ROPE  + 8192;
constexpr size_t OFF_S5E   = OFF_S5KK  + 1048576;
constexpr size_t OFF_S5G   = OFF_S5E   + 8388608;
constexpr size_t OFF_YG    = OFF_S5G   + 8388608;
constexpr size_t OFF_EU    = OFF_YG    + 8388608;
constexpr size_t OFF_SIN   = OFF_EU    + 8388608;
constexpr size_t OFF_BAR   = OFF_SIN   + 4194304;
constexpr size_t OFF_CTR   = OFF_BAR   + 16384;
constexpr size_t WS_TOTAL  = OFF_CTR   + 4096;

constexpr int ZW = 3584;
constexpr size_t OUT_K = 16777216, OUT_V = 25165824, OUT_SRE = 33554432, OUT_SIM = 33685504;
constexpr int LDS_BYTES = 40960;
#ifndef REP_P0
#define REP_P0 1
#endif
#ifndef REP_GIN
#define REP_GIN 1
#endif
#ifndef REP_MIX
#define REP_MIX 1
#endif

__device__ __forceinline__ int opq_v(int x) { asm volatile("" : "+v"(x)); return x; }
__device__ __forceinline__ int opq_s(int x) { asm volatile("" : "+s"(x)); return x; }
__device__ __forceinline__ u16 f2bf(float f) { unsigned u = __float_as_uint(f); u += 0x7fffu + ((u >> 16) & 1u); return (u16)(u >> 16); }
__device__ __forceinline__ float bf2f(u16 h) { return __uint_as_float(((unsigned)h) << 16); }
__device__ __forceinline__ unsigned pack2(float a, float b) { return (unsigned)f2bf(a) | ((unsigned)f2bf(b) << 16); }
__device__ __forceinline__ float silu_f(float x) { return x / (1.f + __expf(-x)); }
__device__ __forceinline__ float warp_sum(float v) { for (int o = 32; o > 0; o >>= 1) v += __shfl_xor(v, o); return v; }
__device__ __forceinline__ f32x16 mfma32(bf16x8 a, bf16x8 b, f32x16 c) { return __builtin_amdgcn_mfma_f32_32x32x16_bf16(a, b, c, 0, 0, 0); }
__device__ __forceinline__ f32x4 mfma16(bf16x8 a, bf16x8 b, f32x4 c) { return __builtin_amdgcn_mfma_f32_16x16x32_bf16(a, b, c, 0, 0, 0); }
__device__ __forceinline__ bf16x8 ld16(const u16* p) { return *reinterpret_cast<const bf16x8*>(p); }
__device__ __forceinline__ bf16x8 zero8() { bf16x8 z = {0, 0, 0, 0, 0, 0, 0, 0}; return z; }
__device__ __forceinline__ float bfl(unsigned w) { return __uint_as_float(w << 16); }
__device__ __forceinline__ float bfh(unsigned w) { return __uint_as_float(w & 0xffff0000u); }

__device__ __forceinline__ const float* xrow(const Params& p, int l, int row) {
  if (l == 0) return row < 8192 ? p.in(0) + (size_t)row * 1024 : p.in(1) + (size_t)(row - 8192) * 1024;
  return p.out() + (size_t)row * 1024;
}
__device__ __forceinline__ int cond_of(int row) { return row < 8192 ? 0 : 1 + ((row - 8192) >> 12); }


#define XB_TMO      128
#define XB_XCNT(j)  (256  + 64 * (j))
#define XB_XSUB(j)  (1280 + 64 * (j))
#define XB_XGEN(j)  (2304 + 64 * (j))
#define XB_TOP      3328
#define XB_TOPGEN   3392
#define XCD_BAR_WORDS 3456
#define XB_SPIN_CAP (1u << 22)
#define LAS __attribute__((address_space(3)))
__device__ __forceinline__ unsigned xb_ld(unsigned* p)              { return __hip_atomic_load(p, __ATOMIC_RELAXED, __HIP_MEMORY_SCOPE_AGENT); }
__device__ __forceinline__ unsigned xb_add(unsigned* p, unsigned v) { return __hip_atomic_fetch_add(p, v, __ATOMIC_RELAXED, __HIP_MEMORY_SCOPE_AGENT); }
__device__ __forceinline__ unsigned xb_xcc_id() { return (unsigned)__builtin_amdgcn_s_getreg((3 << 11) | 20) & 0xFu; }
#define XB_SPIN(cond, bar) do { unsigned _sp = 0; while (cond) { __builtin_amdgcn_s_sleep(1); \
    if ((++_sp & 255u) == 0u) { if (xb_ld(&(bar)[XB_TMO])) break; if (_sp > XB_SPIN_CAP) { atomicAdd(&(bar)[XB_TMO], 1u); break; } } } } while (0)
struct XcdBarrier { unsigned* bar; unsigned x; volatile LAS unsigned* st; };
__device__ __forceinline__ XcdBarrier xcd_barrier_post(unsigned* bar, volatile LAS unsigned* st) {
    XcdBarrier b; b.bar = bar; b.x = xb_xcc_id(); b.st = st;
    if (threadIdx.x == 0) (void)xb_add(&bar[XB_XCNT(b.x)], 1u);
    return b;
}
__device__ __forceinline__ void xcd_barrier_complete(unsigned* bar, unsigned x, unsigned& nloc, unsigned& nx) {
    const unsigned G = gridDim.x * gridDim.y * gridDim.z;
    unsigned sum, cnt, mine, sp = 0u;
    for (;;) {
        sum = 0u; cnt = 0u; mine = 0u;
#pragma unroll
        for (unsigned j = 0; j < 16; ++j) { const unsigned c = xb_ld(&bar[XB_XCNT(j)]); sum += c; cnt += (c > 0u) ? 1u : 0u; mine = (j == x) ? c : mine; }
        if (sum == G) break;
        __builtin_amdgcn_s_sleep(1);
        if ((++sp & 255u) == 0u) { if (xb_ld(&bar[XB_TMO])) break; if (sp > XB_SPIN_CAP) { atomicAdd(&bar[XB_TMO], 1u); break; } }
    }
    nloc = mine > 0u ? mine : 1u; nx = cnt > 0u ? cnt : 1u;
}
__device__ __forceinline__ void xcd_barrier(const XcdBarrier& b) {
    asm volatile("s_waitcnt vmcnt(0)" ::: "memory");
    __syncthreads();
    if (threadIdx.x == 0) {
        unsigned* bar = b.bar;
        __builtin_amdgcn_s_waitcnt(0);
        unsigned nloc = b.st[0], nx = b.st[1];
        if (nloc == 0u) { xcd_barrier_complete(bar, b.x, nloc, nx); b.st[0] = nloc; b.st[1] = nx; }
        const unsigned old = xb_add(&bar[XB_XSUB(b.x)], 1u);
        const unsigned gen = old / nloc;
        if (old + 1u == (gen + 1u) * nloc) {
            __builtin_amdgcn_fence(__ATOMIC_RELEASE, "agent");
            asm volatile("s_waitcnt vmcnt(0)" ::: "memory");
            const unsigned og = xb_add(&bar[XB_TOP], 1u);
            const unsigned tg = og / nx;
            if (og + 1u == (tg + 1u) * nx) xb_add(&bar[XB_TOPGEN], 1u);
            else XB_SPIN(xb_ld(&bar[XB_TOPGEN]) == tg, bar);
            __builtin_amdgcn_fence(__ATOMIC_ACQUIRE, "agent");
            xb_add(&bar[XB_XGEN(b.x)], 1u);
            asm volatile("s_waitcnt vmcnt(0)" ::: "memory");
        } else {
            XB_SPIN(xb_ld(&bar[XB_XGEN(b.x)]) == gen, bar);
            __builtin_amdgcn_fence(__ATOMIC_ACQUIRE, "agent");
            asm volatile("s_waitcnt vmcnt(0)" ::: "memory");
        }
    }
    __syncthreads();
}
__device__ __forceinline__ int next_item(unsigned* ctr, char* smem) {
  volatile int* slot = (volatile int*)(smem + LDS_BYTES + 496);
  __syncthreads();
  if (threadIdx.x == 0) *slot = (int)xb_add(ctr, 1u);
  __syncthreads();
  return *slot;
}

__device__ __forceinline__ void p0_mod(const Params& p, int item, float* lds) {
  const int TIDX = opq_v(threadIdx.x);
  int l = item / 48, n0 = (item % 48) * 64;
  int col = TIDX & 63, ks = TIDX >> 6;
  const float* W = p.in(9) + (size_t)l * 1024 * 3072;
  const float* cc = p.in(6);
  const float* cx = p.in(7);
  float a0 = 0, a1 = 0, a2 = 0;
  for (int k = ks * 256; k < ks * 256 + 256; ++k) {
    float w = W[(size_t)k * 3072 + n0 + col];
    a0 += silu_f(cx[k]) * w; a1 += silu_f(cc[k]) * w; a2 += silu_f(cc[1024 + k]) * w;
  }
  lds[(ks * 3 + 0) * 64 + col] = a0; lds[(ks * 3 + 1) * 64 + col] = a1; lds[(ks * 3 + 2) * 64 + col] = a2;
  __syncthreads();
  if (TIDX < 192) {
    int cnd = TIDX >> 6;
    float s = 0;
    for (int q = 0; q < 4; ++q) s += lds[(q * 3 + cnd) * 64 + col];
    ((float*)(p.ws() + OFF_MOD))[(l * 3 + cnd) * 3072 + n0 + col] = s + p.in(10)[l * 3072 + n0 + col];
  }
  __syncthreads();
}

__device__ __forceinline__ void p0_tr(const float* src, int ldsrc, u16* dst, int lddst, int k0, int n0, float* lds) {
  const int TIDX = opq_v(threadIdx.x);
  for (int e = TIDX; e < 4096; e += 256) { int kk = e >> 6, nn = e & 63; lds[kk * 65 + nn] = src[(size_t)(k0 + kk) * ldsrc + n0 + nn]; }
  __syncthreads();
  for (int e = TIDX; e < 4096; e += 256) { int nn = e >> 6, kk = e & 63; dst[(size_t)(n0 + nn) * lddst + k0 + kk] = f2bf(lds[kk * 65 + nn]); }
  __syncthreads();
}

__device__ __forceinline__ void p0_filter(const Params& p, int l, int lsel, int chunk, float* lds) {
  const int TIDX = opq_v(threadIdx.x);
  const int L = lsel ? 4096 : 256;
  const int t0 = chunk * 32;
  float* feat = lds;
  float* h1 = lds + 1056;
  float* h2 = h1 + 2048;
  const float* w1 = p.in(15) + l * 33 * 64; const float* b1 = p.in(16) + l * 64;
  const float* w2 = p.in(17) + l * 64 * 64; const float* b2 = p.in(18) + l * 64;
  const float* fq = p.in(19) + l * 64;
  const float* w3 = p.in(20) + (size_t)l * 64 * 1024;
  const float* dec = p.in(21) + l * 1024;
  for (int e = TIDX; e < 32 * 33; e += 256) {
    int r = e / 33, f = e % 33; int ti = t0 + r; float v;
    if (f == 0) v = (float)ti / (float)L;
    else {
      int band = f <= 16 ? f : f - 16;
      int rem = (ti * band) % L;
      float ang = 6.283185307179586f * ((float)rem / (float)L);
      v = f <= 16 ? cosf(ang) : sinf(ang);
    }
    feat[e] = v;
  }
  __syncthreads();
  for (int e = TIDX; e < 2048; e += 256) {
    int r = e >> 6, j = e & 63; float s = b1[j];
    for (int f = 0; f < 33; ++f) s += feat[r * 33 + f] * w1[f * 64 + j];
    h1[e] = sinf(fq[j] * s);
  }
  __syncthreads();
  for (int e = TIDX; e < 2048; e += 256) {
    int r = e >> 6, j = e & 63; float s = b2[j];
    for (int k = 0; k < 64; ++k) s += h1[r * 64 + k] * w2[k * 64 + j];
    h2[e] = sinf(fq[j] * s);
  }
  __syncthreads();
  u16* taps = (u16*)(p.ws() + OFF_TAPS + l * TAPS_LAYER + (lsel ? 0 : 8388608));
  float* psum = (float*)(p.ws() + OFF_PSUM + l * PSUM_LAYER) + (lsel ? 0 : 128 * 1024) + chunk * 1024;
  for (int q = 0; q < 4; ++q) {
    int col = q * 256 + TIDX;
    float w[64];
#pragma unroll
    for (int k = 0; k < 64; ++k) w[k] = w3[k * 1024 + col];
    float ad = fabsf(dec[col]);
    bool isb = (col & 256) != 0;
    float asum = 0;
    for (int r8 = 0; r8 < 4; ++r8) {
      unsigned pk[4];
#pragma unroll
      for (int rr = 0; rr < 8; ++rr) {
        int r = r8 * 8 + rr;
        float s = 0;
#pragma unroll
        for (int k = 0; k < 64; ++k) s += h2[r * 64 + k] * w[k];
        int ti = t0 + r;
        s *= __expf(-((float)ti / (float)L) * ad);
        if (!(isb && ti == 0)) asum += fabsf(s);
        u16 hb = f2bf(s);
        if (rr & 1) pk[rr >> 1] |= ((unsigned)hb) << 16; else pk[rr >> 1] = hb;
      }
      u32x4 v = {pk[0], pk[1], pk[2], pk[3]};
      *reinterpret_cast<u32x4*>(taps + (size_t)col * L + t0 + r8 * 8) = v;
    }
    psum[col] = asum;
  }
  __syncthreads();
}

__device__ __forceinline__ void p0_s5(const Params& p, int l, int g, int dir, float* lds) {
  const int TIDX = opq_v(threadIdx.x);
  float2* pw = (float2*)lds;
  float2* bb = pw + 33 * 64;
  float2* cm = bb + 1024;
  const int base = ((l * 2 + dir) * 16 + g);
  const float dt = expf(p.in(26)[base]);
  const int tid = TIDX;
  for (int e = tid; e < 33 * 64; e += 256) {
    int m = e >> 6, pp = e & 63;
    float ar = p.in(24)[base * 64 + pp], ai = p.in(25)[base * 64 + pp];
    float mag = expf(ar * dt * (float)m);
    float ang = ai * dt;
    double angm = (double)ang * (double)m;
    double tw = angm * 0.15915494309189535;
    tw -= floor(tw);
    float a = (float)(tw * 6.283185307179586);
    float sn, cs; sincosf(a, &sn, &cs);
    pw[e] = make_float2(mag * cs, mag * sn);
  }
  for (int e = tid; e < 1024; e += 256) {
    int pp = e >> 4, c = e & 15;
    float ar = p.in(24)[base * 64 + pp], ai = p.in(25)[base * 64 + pp];
    float mag = expf(ar * dt); float sn, cs; sincosf(ai * dt, &sn, &cs);
    float nr = mag * cs - 1.f, ni = mag * sn;
    float den = ar * ar + ai * ai;
    float qr = (nr * ar + ni * ai) / den, qi = (ni * ar - nr * ai) / den;
    float br = p.in(27)[(size_t)base * 1024 + e], bi = p.in(28)[(size_t)base * 1024 + e];
    bb[e] = make_float2(qr * br - qi * bi, qr * bi + qi * br);
    int c2 = e >> 6, p2 = e & 63;
    cm[e] = make_float2(p.in(29)[(size_t)base * 1024 + c2 * 64 + p2], p.in(30)[(size_t)base * 1024 + c2 * 64 + p2]);
  }
  __syncthreads();
  const int lg = l * 16 + g;
  u16* KK = (u16*)(p.ws() + OFF_S5KK) + ((size_t)lg * 2 + dir) * 8192;
  for (int e = tid; e < 8192; e += 256) {
    int m = e >> 8, c = (e >> 4) & 15, c2 = e & 15;
    float s = 0;
    for (int pp = 0; pp < 64; ++pp) {
      float2 C = cm[c * 64 + pp], W = pw[m * 64 + pp], B = bb[pp * 16 + c2];
      float tr = C.x * W.x - C.y * W.y, ti = C.x * W.y + C.y * W.x;
      s += tr * B.x - ti * B.y;
    }
    KK[e] = f2bf(s);
  }
  u16* E = (u16*)(p.ws() + OFF_S5E) + (size_t)lg * 256 * 512;
  for (int e = tid; e < 64 * 512; e += 256) {
    int pp = e >> 9, k = e & 511, j = k >> 4, c2 = k & 15;
    float2 W = pw[(dir == 0 ? 31 - j : j) * 64 + pp], B = bb[pp * 16 + c2];
    float vr = W.x * B.x - W.y * B.y, vi = W.x * B.y + W.y * B.x;
    E[(size_t)(dir * 128 + pp) * 512 + k] = f2bf(vr);
    E[(size_t)(dir * 128 + 64 + pp) * 512 + k] = f2bf(vi);
  }
  u16* G = (u16*)(p.ws() + OFF_S5G) + (size_t)lg * 512 * 256;
  for (int e = tid; e < 512 * 64; e += 256) {
    int row = e >> 6, pp = e & 63, i = row >> 4, c = row & 15;
    float2 C = cm[c * 64 + pp], W = pw[(dir == 0 ? i + 1 : 32 - i) * 64 + pp];
    float tr = C.x * W.x - C.y * W.y, ti = C.x * W.y + C.y * W.x;
    G[(size_t)row * 256 + dir * 128 + pp] = f2bf(tr);
    G[(size_t)row * 256 + dir * 128 + 64 + pp] = f2bf(-ti);
  }
  __syncthreads();
}

__device__ __forceinline__ void p0_cache(const Params& p, int item) {
  const int TIDX = opq_v(threadIdx.x);
  int l = item >> 4, b = (item >> 3) & 1, h = item & 7;
  const float* ck = p.in(2) + ((size_t)((b * 2 + l) * 8 + h)) * 16384;
  const float* cv = p.in(3) + ((size_t)((b * 2 + l) * 8 + h)) * 16384;
  u16* ok = (u16*)(p.ws() + OFF_CKB) + (size_t)item * 16384;
  u16* ov = (u16*)(p.ws() + OFF_CVT) + (size_t)item * 16384;
  for (int e = TIDX; e < 16384; e += 256) {
    ok[e] = f2bf(ck[e]);
    int d = e >> 8, key = e & 255;
    ov[e] = f2bf(cv[key * 64 + d]);
  }
}

__device__ __forceinline__ void phase0(const Params& p, float* lds) {
  const int TIDX = opq_v(threadIdx.x);
  const int BIDX = opq_s(blockIdx.x);
  const int N_FILT = 272, N_S5 = 64, N_MOD = 96, N_WIN = 1792, N_WOUT = 512, N_GLU = 32, N_CACHE = 32, N_ROPE = 1;
  const int total = N_FILT + N_S5 + N_MOD + N_WIN + N_WOUT + N_GLU + N_CACHE + N_ROPE;
  if (BIDX == 0) { unsigned* bz = (unsigned*)(p.ws() + OFF_BAR); for (int e = TIDX; e < (16384 + 4096) / 4; e += 256) bz[e] = 0u; }
  for (int it = BIDX; it < total; it += gridDim.x) {
    int i = it;
    if (i < N_FILT) {
      int l = i / 136, r = i % 136;
      if (r < 128) p0_filter(p, l, 1, r, lds); else p0_filter(p, l, 0, r - 128, lds);
      continue;
    }
    i -= N_FILT;
    if (i < N_S5) { p0_s5(p, i >> 5, (i >> 1) & 15, i & 1, lds); continue; }
    i -= N_S5;
    if (i < N_MOD) { p0_mod(p, i, lds); continue; }
    i -= N_MOD;
    if (i < N_WIN) {
      int l = i / 896, r = i % 896;
      p0_tr(p.in(11) + (size_t)l * 1024 * 3584, 3584, (u16*)(p.ws() + OFF_WINT) + (size_t)l * 3584 * 1024, 1024, (r / 56) * 64, (r % 56) * 64, lds);
      continue;
    }
    i -= N_WIN;
    if (i < N_WOUT) {
      int l = i >> 8, r = i & 255;
      p0_tr(p.in(12) + (size_t)l * 1024 * 1024, 1024, (u16*)(p.ws() + OFF_WOUTT) + (size_t)l * 1024 * 1024, 1024, (r >> 4) * 64, (r & 15) * 64, lds);
      continue;
    }
    i -= N_WOUT;
    if (i < N_GLU) {
      int l = i >> 4, r = i & 15;
      p0_tr(p.in(32) + (size_t)l * 65536, 256, (u16*)(p.ws() + OFF_GLUT) + (size_t)l * 65536, 256, (r >> 2) * 64, (r & 3) * 64, lds);
      continue;
    }
    i -= N_GLU;
    if (i < N_CACHE) { p0_cache(p, i); continue; }
    float2* tab = (float2*)(p.ws() + OFF_ROPE);
    for (int e = TIDX; e < 1024; e += 256) {
      int pos = e >> 4, k = e & 15;
      float inv = expf(-(float)k * (9.210340371976184f / 16.f));
      float sn, cs; sincosf((float)pos * inv, &sn, &cs);
      tab[e] = make_float2(cs, sn);
    }
  }
}

__device__ __forceinline__ void phase_prenorm(const Params& p, int l) {
  const int TIDX = opq_v(threadIdx.x);
  const int BIDX = opq_s(blockIdx.x);
  const float* mod = (const float*)(p.ws() + OFF_MOD) + l * 3 * 3072;
  const float* ng = p.in(8) + l * 1024;
  u16* hbf = (u16*)(p.ws() + OFF_HBF);
  int wave = TIDX >> 6, lane = TIDX & 63;
  for (int row = BIDX * 4 + wave; row < 16384; row += gridDim.x * 4) {
    const float* x = xrow(p, l, row);
    const float* md = mod + cond_of(row) * 3072;
    float4 v[4]; float ss = 0;
#pragma unroll
    for (int i = 0; i < 4; ++i) { v[i] = *(const float4*)(x + i * 256 + lane * 4); ss += v[i].x * v[i].x + v[i].y * v[i].y + v[i].z * v[i].z + v[i].w * v[i].w; }
    ss = warp_sum(ss);
    float rstd = rsqrtf(ss * (1.f / 1024.f) + 1e-6f);
#pragma unroll
    for (int i = 0; i < 4; ++i) {
      int col = i * 256 + lane * 4;
      float4 g = *(const float4*)(ng + col), sh = *(const float4*)(md + col), sc = *(const float4*)(md + 1024 + col);
      float h0 = v[i].x * rstd * g.x * (1.f + sc.x) + sh.x;
      float h1 = v[i].y * rstd * g.y * (1.f + sc.y) + sh.y;
      float h2 = v[i].z * rstd * g.z * (1.f + sc.z) + sh.z;
      float h3 = v[i].w * rstd * g.w * (1.f + sc.w) + sh.w;
      u32x2 o = {pack2(h0, h1), pack2(h2, h3)};
      *reinterpret_cast<u32x2*>(hbf + (size_t)row * 1024 + col) = o;
    }
  }
}

__device__ __forceinline__ void phase_finalnorm(const Params& p) {
  const int TIDX = opq_v(threadIdx.x);
  const int BIDX = opq_s(blockIdx.x);
  const float* ng = p.in(34);
  int wave = TIDX >> 6, lane = TIDX & 63;
  for (int row = BIDX * 4 + wave; row < 16384; row += gridDim.x * 4) {
    float* x = p.out() + (size_t)row * 1024;
    float4 v[4]; float ss = 0;
#pragma unroll
    for (int i = 0; i < 4; ++i) { v[i] = *(const float4*)(x + i * 256 + lane * 4); ss += v[i].x * v[i].x + v[i].y * v[i].y + v[i].z * v[i].z + v[i].w * v[i].w; }
    ss = warp_sum(ss);
    float rstd = rsqrtf(ss * (1.f / 1024.f) + 1e-6f);
#pragma unroll
    for (int i = 0; i < 4; ++i) {
      int col = i * 256 + lane * 4;
      float4 g = *(const float4*)(ng + col);
      float4 o = make_float4(v[i].x * rstd * g.x, v[i].y * rstd * g.y, v[i].z * rstd * g.z, v[i].w * rstd * g.w);
      *(float4*)(x + col) = o;
    }
  }
}

template <bool SWAP>
__device__ __forceinline__ void gemm_mainloop(const u16* __restrict__ A, const u16* __restrict__ Bt, int m0, int n0, char* smem, f32x4 (&acc)[4][4]) {
  const int tid = opq_v(threadIdx.x), lane = tid & 63, wid = tid >> 6, wm = wid >> 1, wn = wid & 1, fr = lane & 15, fq = lane >> 4;
  char* sA = smem; char* sB = smem + 16384;
  for (int kt = 0; kt < 16; ++kt) {
#pragma unroll
    for (int i = 0; i < 4; ++i) {
      int pch = i * 256 + tid; int r = pch >> 3, cp = pch & 7; int c = cp ^ ((r >> 1) & 7);
      __builtin_amdgcn_global_load_lds((const unsigned*)(A + (size_t)(m0 + r) * 1024 + kt * 64 + c * 8), (__attribute__((address_space(3))) unsigned*)(sA + pch * 16), 16, 0, 0);
      __builtin_amdgcn_global_load_lds((const unsigned*)(Bt + (size_t)(n0 + r) * 1024 + kt * 64 + c * 8), (__attribute__((address_space(3))) unsigned*)(sB + pch * 16), 16, 0, 0);
    }
    __syncthreads();
#pragma unroll
    for (int ks = 0; ks < 2; ++ks) {
      bf16x8 xa[4], wb[4];
#pragma unroll
      for (int t = 0; t < 4; ++t) {
        int c = ks * 4 + fq;
        int r = wm * 64 + t * 16 + fr;
        xa[t] = *(const bf16x8*)(sA + (r * 8 + (c ^ ((r >> 1) & 7))) * 16);
        int rn = wn * 64 + t * 16 + fr;
        wb[t] = *(const bf16x8*)(sB + (rn * 8 + (c ^ ((rn >> 1) & 7))) * 16);
      }
#pragma unroll
      for (int mt = 0; mt < 4; ++mt)
#pragma unroll
        for (int nt = 0; nt < 4; ++nt)
          acc[mt][nt] = SWAP ? mfma16(wb[nt], xa[mt], acc[mt][nt]) : mfma16(xa[mt], wb[nt], acc[mt][nt]);
    }
    __syncthreads();
  }
}

__device__ __forceinline__ void phase_gemm_in(const Params& p, int l, char* smem) {
  const int TIDX = opq_v(threadIdx.x);
  const int BIDX = opq_s(blockIdx.x);
  const u16* A = (const u16*)(p.ws() + OFF_HBF);
  const u16* Bt = (const u16*)(p.ws() + OFF_WINT) + (size_t)l * 3584 * 1024;
  u16* z = (u16*)(p.ws() + OFF_Z);
  u16* qrot = (u16*)(p.ws() + OFF_QROT);
  u16* vT = (u16*)(p.ws() + OFF_VT);
  const float2* tab = (const float2*)(p.ws() + OFF_ROPE);
  const int lane = TIDX & 63, wid = TIDX >> 6, wm = wid >> 1, wn = wid & 1, fr = lane & 15, fq = lane >> 4;
  for (int tile = BIDX; tile < 128 * 28; tile += gridDim.x) {
    int m0 = (tile / 28) * 128, n0 = (tile % 28) * 128;
    f32x4 acc[4][4];
#pragma unroll
    for (int a = 0; a < 4; ++a)
#pragma unroll
      for (int b = 0; b < 4; ++b) acc[a][b] = f32x4{0.f, 0.f, 0.f, 0.f};
    const bool vtile = n0 >= 1792 && n0 < 2304;
    if (vtile) {
      gemm_mainloop<false>(A, Bt, m0, n0, smem, acc);
#pragma unroll
      for (int mt = 0; mt < 4; ++mt)
#pragma unroll
        for (int nt = 0; nt < 4; ++nt) {
          int m = m0 + wm * 64 + mt * 16 + fq * 4, n = n0 + wn * 64 + nt * 16 + fr - 1792;
          f32x4 v = acc[mt][nt];
          u32x2 o = {pack2(v[0], v[1]), pack2(v[2], v[3])};
          *reinterpret_cast<u32x2*>(vT + (size_t)n * 16384 + m) = o;
          if (m0 < 8192) {
            int b = m >> 8, t = m & 255, head = n >> 6, d = n & 63;
            float* o2 = p.out() + OUT_V + ((size_t)((b * 2 + l) * 8 + head) * 256 + t) * 64 + d;
            o2[0] = v[0]; o2[64] = v[1]; o2[128] = v[2]; o2[192] = v[3];
          }
        }
    } else {
      gemm_mainloop<true>(A, Bt, m0, n0, smem, acc);
      const int nbase = n0 + wn * 64;
      const bool lat = m0 >= 8192;
      const bool isq = nbase >= 768 && nbase < 1280, isk = nbase >= 1280 && nbase < 1792;
#pragma unroll
      for (int mt = 0; mt < 4; ++mt) {
        int m = m0 + wm * 64 + mt * 16 + fr;
        if (!(lat && isk)) {
#pragma unroll
          for (int nt = 0; nt < 4; ++nt) {
            f32x4 v = acc[mt][nt];
            u32x2 o = {pack2(v[0], v[1]), pack2(v[2], v[3])};
            *reinterpret_cast<u32x2*>(z + (size_t)m * ZW + nbase + nt * 16 + fq * 4) = o;
          }
        }
        if (!lat && isk) {
          int b = m >> 8, t = m & 255, head = (nbase - 1280) >> 6;
          float* o2 = p.out() + OUT_K + ((size_t)((b * 2 + l) * 8 + head) * 256 + t) * 64 + fq * 4;
#pragma unroll
          for (int nt = 0; nt < 4; ++nt) *(float4*)(o2 + nt * 16) = make_float4(acc[mt][nt][0], acc[mt][nt][1], acc[mt][nt][2], acc[mt][nt][3]);
        }
        if (lat && (isq || isk)) {
          int ml = (m - 8192) & 4095; int prow = ml >> 6, pcol = ml & 63;
          f32x4 r[4];
#pragma unroll
          for (int j = 0; j < 4; ++j) {
            float2 a = tab[prow * 16 + fq * 4 + j], b = tab[pcol * 16 + fq * 4 + j];
            float x1 = acc[mt][0][j], x2 = acc[mt][1][j];
            r[0][j] = x1 * a.x - x2 * a.y; r[1][j] = x2 * a.x + x1 * a.y;
            x1 = acc[mt][2][j]; x2 = acc[mt][3][j];
            r[2][j] = x1 * b.x - x2 * b.y; r[3][j] = x2 * b.x + x1 * b.y;
          }
          u16* dst = isq ? qrot + (size_t)(m - 8192) * 512 + (nbase - 768) + fq * 4 : z + (size_t)m * ZW + nbase + fq * 4;
#pragma unroll
          for (int nt = 0; nt < 4; ++nt) {
            u32x2 o = {pack2(r[nt][0], r[nt][1]), pack2(r[nt][2], r[nt][3])};
            *reinterpret_cast<u32x2*>(dst + nt * 16) = o;
          }
        }
      }
    }
  }
}

__device__ __forceinline__ void phase_gemm_out(const Params& p, int l, char* smem) {
  const int TIDX = opq_v(threadIdx.x);
  const int BIDX = opq_s(blockIdx.x);
  const u16* A = (const u16*)(p.ws() + OFF_HBF);
  const u16* Bt = (const u16*)(p.ws() + OFF_WOUTT) + (size_t)l * 1024 * 1024;
  const float* mod = (const float*)(p.ws() + OFF_MOD) + l * 3 * 3072;
  const int lane = TIDX & 63, wid = TIDX >> 6, wm = wid >> 1, wn = wid & 1, fr = lane & 15, fq = lane >> 4;
  for (int tile = BIDX; tile < 128 * 8; tile += gridDim.x) {
    int m0 = (tile >> 3) * 128, n0 = (tile & 7) * 128;
    f32x4 acc[4][4];
#pragma unroll
    for (int a = 0; a < 4; ++a)
#pragma unroll
      for (int b = 0; b < 4; ++b) acc[a][b] = f32x4{0.f, 0.f, 0.f, 0.f};
    gemm_mainloop<true>(A, Bt, m0, n0, smem, acc);
#pragma unroll
    for (int mt = 0; mt < 4; ++mt) {
      int m = m0 + wm * 64 + mt * 16 + fr;
      const float* xr = xrow(p, l, m);
      const float* gate = mod + cond_of(m) * 3072 + 2048;
#pragma unroll
      for (int nt = 0; nt < 4; ++nt) {
        int n = n0 + wn * 64 + nt * 16 + fq * 4;
        float4 x = *(const float4*)(xr + n), g = *(const float4*)(gate + n);
        f32x4 v = acc[mt][nt];
        *(float4*)(p.out() + (size_t)m * 1024 + n) = make_float4(x.x + g.x * v[0], x.y + g.y * v[1], x.z + g.z * v[2], x.w + g.w * v[3]);
      }
    }
  }
}

struct AttState { float m, l; f32x16 o0, o1; };

__device__ __forceinline__ void attn_tile(const f32x16& s, AttState& st, const u16* vt, size_t vstride, int lane) {
  float mx = s[0];
#pragma unroll
  for (int i = 1; i < 16; ++i) mx = fmaxf(mx, s[i]);
  mx = fmaxf(mx, __shfl_xor(mx, 32));
  float mn = fmaxf(st.m, mx);
  float alpha = __expf(st.m - mn);
  float pv[16]; float ps = 0;
#pragma unroll
  for (int i = 0; i < 16; ++i) { pv[i] = __expf(s[i] - mn); ps += pv[i]; }
  st.l = st.l * alpha + ps; st.m = mn;
#pragma unroll
  for (int i = 0; i < 16; ++i) { st.o0[i] *= alpha; st.o1[i] *= alpha; }
  const int d = lane & 31, h = lane >> 5;
#pragma unroll
  for (int sp = 0; sp < 2; ++sp) {
    u32x4 pw = {pack2(pv[8 * sp], pv[8 * sp + 1]), pack2(pv[8 * sp + 2], pv[8 * sp + 3]), pack2(pv[8 * sp + 4], pv[8 * sp + 5]), pack2(pv[8 * sp + 6], pv[8 * sp + 7])};
    bf16x8 pf = __builtin_bit_cast(bf16x8, pw);
    const u16* v0 = vt + (size_t)d * vstride + 16 * sp + 4 * h;
    u32x2 a0 = *reinterpret_cast<const u32x2*>(v0), a1 = *reinterpret_cast<const u32x2*>(v0 + 8);
    u32x4 va = {a0[0], a0[1], a1[0], a1[1]};
    st.o0 = mfma32(__builtin_bit_cast(bf16x8, va), pf, st.o0);
    const u16* v1 = v0 + 32 * vstride;
    u32x2 b0 = *reinterpret_cast<const u32x2*>(v1), b1 = *reinterpret_cast<const u32x2*>(v1 + 8);
    u32x4 vb = {b0[0], b0[1], b1[0], b1[1]};
    st.o1 = mfma32(__builtin_bit_cast(bf16x8, vb), pf, st.o1);
  }
}

__device__ __forceinline__ void attn_finish(AttState& st, const u16* z, u16* ybf, int tok, int head, int lane) {
  float lt = st.l + __shfl_xor(st.l, 32);
  float inv = 1.f / lt;
  const int h = lane >> 5;
#pragma unroll
  for (int dt = 0; dt < 2; ++dt)
#pragma unroll
    for (int rg = 0; rg < 4; ++rg) {
      int d0 = dt * 32 + 8 * rg + 4 * h;
      u32x2 gg = *reinterpret_cast<const u32x2*>(z + (size_t)tok * ZW + 2560 + 256 + head * 64 + d0);
      float o[4];
#pragma unroll
      for (int i = 0; i < 4; ++i) o[i] = (dt ? st.o1[4 * rg + i] : st.o0[4 * rg + i]) * inv;
      o[0] *= silu_f(bfl(gg[0])); o[1] *= silu_f(bfh(gg[0])); o[2] *= silu_f(bfl(gg[1])); o[3] *= silu_f(bfh(gg[1]));
      u32x2 ov = {pack2(o[0], o[1]), pack2(o[2], o[3])};
      *reinterpret_cast<u32x2*>(ybf + (size_t)tok * 1024 + 256 + head * 64 + d0) = ov;
    }
}

__device__ __forceinline__ void attn_ctx_item(const Params& p, int item) {
  const int TIDX = opq_v(threadIdx.x);
  const int b = item >> 3, head = item & 7;
  const u16* z = (const u16*)(p.ws() + OFF_Z);
  const u16* vT = (const u16*)(p.ws() + OFF_VT);
  u16* ybf = (u16*)(p.ws() + OFF_HBF);
  const int lane = TIDX & 63, wid = TIDX >> 6, r = lane & 31, h = lane >> 5;
  const int tok0 = b * 256;
  for (int pass = 0; pass < 2; ++pass) {
    const int qt = wid + 4 * pass;
    const int qtok = tok0 + qt * 32 + r;
    bf16x8 qf[4];
#pragma unroll
    for (int ks = 0; ks < 4; ++ks) qf[ks] = ld16(z + (size_t)qtok * ZW + 768 + head * 64 + ks * 16 + 8 * h);
    AttState st; st.m = -1e30f; st.l = 0.f;
#pragma unroll
    for (int i = 0; i < 16; ++i) { st.o0[i] = 0.f; st.o1[i] = 0.f; }
    for (int kt = 0; kt < 8; ++kt) {
      f32x16 s;
#pragma unroll
      for (int i = 0; i < 16; ++i) s[i] = 0.f;
      const u16* kp = z + (size_t)(tok0 + kt * 32 + r) * ZW + 1280 + head * 64 + 8 * h;
#pragma unroll
      for (int ks = 0; ks < 4; ++ks) s = mfma32(ld16(kp + ks * 16), qf[ks], s);
#pragma unroll
      for (int i = 0; i < 16; ++i) s[i] *= 0.125f;
      attn_tile(s, st, vT + (size_t)(head * 64) * 16384 + tok0 + kt * 32, 16384, lane);
    }
    attn_finish(st, z, ybf, qtok, head, lane);
  }
}

__device__ __forceinline__ void attn_lat_item(const Params& p, int l, int item) {
  const int TIDX = opq_v(threadIdx.x);
  const int b = item >> 8, head = (item >> 5) & 7, rp = item & 31;
  const u16* z = (const u16*)(p.ws() + OFF_Z);
  const u16* vT = (const u16*)(p.ws() + OFF_VT);
  const u16* qrot = (const u16*)(p.ws() + OFF_QROT);
  u16* ybf = (u16*)(p.ws() + OFF_HBF);
  const int lane = TIDX & 63, wid = TIDX >> 6, r = lane & 31, h = lane >> 5;
  const int grow = rp * 2 + (wid >> 1), qt = wid & 1;
  const int qc = qt * 32 + r;
  const int ltok = b * 4096 + grow * 64 + qc;
  const int qtok = 8192 + ltok;
  AttState st; st.m = -1e30f; st.l = 0.f;
#pragma unroll
  for (int i = 0; i < 16; ++i) { st.o0[i] = 0.f; st.o1[i] = 0.f; }
  {
    bf16x8 qf[4];
#pragma unroll
    for (int ks = 0; ks < 4; ++ks) qf[ks] = ld16(z + (size_t)qtok * ZW + 768 + head * 64 + ks * 16 + 8 * h);
    const u16* ck = (const u16*)(p.ws() + OFF_CKB) + (size_t)((l * 2 + b) * 8 + head) * 16384;
    const u16* cv = (const u16*)(p.ws() + OFF_CVT) + (size_t)((l * 2 + b) * 8 + head) * 16384;
    for (int kt = 0; kt < 8; ++kt) {
      f32x16 s;
#pragma unroll
      for (int i = 0; i < 16; ++i) s[i] = 0.f;
      const u16* kp = ck + (size_t)(kt * 32 + r) * 64 + 8 * h;
#pragma unroll
      for (int ks = 0; ks < 4; ++ks) s = mfma32(ld16(kp + ks * 16), qf[ks], s);
#pragma unroll
      for (int i = 0; i < 16; ++i) s[i] *= 0.125f;
      attn_tile(s, st, cv + kt * 32, 256, lane);
    }
  }
  {
    bf16x8 qf[4];
#pragma unroll
    for (int ks = 0; ks < 4; ++ks) qf[ks] = ld16(qrot + (size_t)ltok * 512 + head * 64 + ks * 16 + 8 * h);
    const float* rpb = p.in(23) + (size_t)(l * 8 + head) * 15 * 31;
    int rs = grow - 4; rs = rs < 0 ? 0 : (rs > 56 ? 56 : rs);
    int cstart = qc - 8; cstart = cstart < 0 ? 0 : (cstart > 48 ? 48 : cstart);
    for (int wi = 0; wi < 8; ++wi) {
      const int kr = rs + wi;
      const float* rb = rpb + (kr - grow + 7) * 31;
      for (int hf = 0; hf < 2; ++hf) {
        const int ktok = 8192 + b * 4096 + kr * 64 + hf * 32;
        f32x16 s;
#pragma unroll
        for (int i = 0; i < 16; ++i) s[i] = 0.f;
        const u16* kp = z + (size_t)(ktok + r) * ZW + 1280 + head * 64 + 8 * h;
#pragma unroll
        for (int ks = 0; ks < 4; ++ks) s = mfma32(ld16(kp + ks * 16), qf[ks], s);
#pragma unroll
        for (int i = 0; i < 16; ++i) {
          int kc = hf * 32 + (i & 3) + 8 * (i >> 2) + 4 * h;
          bool valid = kc >= cstart && kc < cstart + 16;
          int ci = kc - qc + 15; ci = ci < 0 ? 0 : (ci > 30 ? 30 : ci);
          float bias = rb[ci];
          s[i] = valid ? s[i] * 0.125f + bias : -INFINITY;
        }
        attn_tile(s, st, vT + (size_t)(head * 64) * 16384 + ktok, 16384, lane);
      }
    }
  }
  attn_finish(st, z, ybf, qtok, head, lane);
}

__device__ __forceinline__ float hy_zc(const u16* zcol, int t, int L, float w0, float w1, float w2, float bias) {
  float a = bias + w1 * bf2f(zcol[(size_t)t * ZW]);
  if (t > 0) a += w0 * bf2f(zcol[(size_t)(t - 1) * ZW]);
  if (t < L - 1) a += w2 * bf2f(zcol[(size_t)(t + 1) * ZW]);
  return a;
}

__device__ __forceinline__ void hyena_lat_item(const Params& p, int l, int ch, char* smem) {
  const int TIDX = opq_v(threadIdx.x);
  u16* Hs = (u16*)smem;
  u16* UR = (u16*)(smem + 18432);
  float* red = (float*)(smem + 18432 + 16960);
  const u16* z = (const u16*)(p.ws() + OFF_Z);
  u16* ybf = (u16*)(p.ws() + OFF_HBF);
  const u16* taps = (const u16*)(p.ws() + OFF_TAPS + l * TAPS_LAYER);
  const float* psum = (const float*)(p.ws() + OFF_PSUM + l * PSUM_LAYER);
  const float* cw = p.in(13) + l * 3 * 768; const float* cb = p.in(14) + l * 768;
  const int tid = TIDX, lane = tid & 63, wid = tid >> 6;
  {
    int o = tid >> 7, idx = tid & 127;
    float s = psum[idx * 1024 + o * 512 + ch] + psum[idx * 1024 + o * 512 + 256 + ch];
    s = warp_sum(s);
    if (lane == 0) red[wid] = s;
  }
  {
    float w0 = cw[ch], w1 = cw[768 + ch], w2 = cw[1536 + ch], bs = cb[ch];
    for (int e = tid; e < 2 * 4240; e += 256) {
      int b = e / 4240, i = e % 4240; int t = 4159 - i;
      float v = 0.f;
      if (t >= 0 && t < 4096) v = hy_zc(z + (size_t)(8192 + b * 4096) * ZW + ch, t, 4096, w0, w1, w2, bs);
      UR[e] = f2bf(v);
    }
  }
  __syncthreads();
  const int bsel = wid >> 1, chalf = wid & 1;
  const int r = lane & 31, g = lane >> 5;
  const int c = chalf * 32 + r;
  for (int o = 0; o < 2; ++o) {
    const float inv = 1.f / (red[o * 2] + red[o * 2 + 1]);
    const u16* tf = taps + (size_t)(o * 512 + ch) * 4096;
    const u16* tb = taps + (size_t)(o * 512 + 256 + ch) * 4096;
    for (int i = tid; i < 8192; i += 256) {
      float v = 0.f;
      if (i >= 4096) v = bf2f(tf[i - 4096]); else if (i > 0) v = bf2f(tb[4096 - i]);
      Hs[i + 8 * (i >> 6)] = f2bf(v * inv);
    }
    __syncthreads();
    f32x16 acc0, acc1;
#pragma unroll
    for (int i = 0; i < 16; ++i) { acc0[i] = 0.f; acc1[i] = 0.f; }
    {
      const int start0 = 63 - c + 8 * g;
      const unsigned sh = (start0 & 1) * 16;
      const unsigned* bp = (const unsigned*)(UR + bsel * 4240 + (start0 & ~1));
      for (int ks = 0; ks < 260; ++ks) {
        const unsigned* q = bp + ks * 8;
        unsigned d0 = q[0], d1 = q[1], d2 = q[2], d3 = q[3], d4 = q[4];
        u32x4 bw = {__builtin_amdgcn_alignbit(d1, d0, sh), __builtin_amdgcn_alignbit(d2, d1, sh), __builtin_amdgcn_alignbit(d3, d2, sh), __builtin_amdgcn_alignbit(d4, d3, sh)};
        bf16x8 bf = __builtin_bit_cast(bf16x8, bw);
        int x = 16 * ks + 8 * g;
        int pos0 = 72 * (r + (x >> 6)) + (x & 63);
        bf16x8 a0 = ld16(Hs + pos0);
        bf16x8 a1 = ld16(Hs + pos0 + 72 * 32);
        acc0 = mfma32(a0, bf, acc0);
        acc1 = mfma32(a1, bf, acc1);
      }
    }
    const int gcol = o == 0 ? 256 + ch : 512 + ch;
    const float w0 = cw[gcol], w1 = cw[768 + gcol], w2 = cw[1536 + gcol], bs = cb[gcol];
    const float hb = p.in(22)[(l * 2 + o) * 256 + ch];
    const u16* zg = z + (size_t)(8192 + bsel * 4096) * ZW + gcol;
#pragma unroll
    for (int i0 = 0; i0 < 32; i0 += 4) {
#pragma unroll
      for (int ii = 0; ii < 4; ++ii) {
        const int i = i0 + ii;
        int row = (i & 3) + 8 * ((i & 15) >> 2) + 4 * g + 32 * (i >> 4);
        int t = 64 * row + c;
        asm volatile("" : "+v"(t));
        float conv = i < 16 ? acc0[i & 15] : acc1[i & 15];
        float uv = bf2f(UR[bsel * 4240 + 4159 - t]);
        float xg = hy_zc(zg, t, 4096, w0, w1, w2, bs);
        float rv = xg * (conv + hb * uv);
        if (o == 1) {
          size_t tok = 8192 + bsel * 4096 + t;
          float gv = bf2f(z[tok * ZW + 2560 + ch]);
          ybf[tok * 1024 + ch] = f2bf(rv * silu_f(gv));
        }
        if (i < 16) acc0[i & 15] = rv; else acc1[i & 15] = rv;
      }
      __builtin_amdgcn_sched_barrier(0);
    }
    __syncthreads();
    if (o == 0) {
#pragma unroll
      for (int i = 0; i < 32; ++i) {
        int row = (i & 3) + 8 * ((i & 15) >> 2) + 4 * g + 32 * (i >> 4);
        int t = 64 * row + c;
        UR[bsel * 4240 + 4159 - t] = f2bf(i < 16 ? acc0[i & 15] : acc1[i & 15]);
      }
    }
    __syncthreads();
  }
}

__device__ __forceinline__ void hyena_ctx_item(const Params& p, int l, int item, char* smem) {
  const int TIDX = opq_v(threadIdx.x);
  const int b = item >> 6, cg4 = item & 63;
  const int tid = TIDX, lane = tid & 63, wid = tid >> 6;
  const int ch = cg4 * 4 + wid;
  float* Hs = (float*)smem + wid * 1024;
  float* U = Hs + 512;
  const u16* z = (const u16*)(p.ws() + OFF_Z);
  u16* ybf = (u16*)(p.ws() + OFF_HBF);
  const u16* taps = (const u16*)(p.ws() + OFF_TAPS + l * TAPS_LAYER + 8388608);
  const float* psum = (const float*)(p.ws() + OFF_PSUM + l * PSUM_LAYER) + 128 * 1024;
  const float* cw = p.in(13) + l * 3 * 768; const float* cb = p.in(14) + l * 768;
  const u16* zs = z + (size_t)(b * 256) * ZW;
  float vv[4];
  {
    float w0 = cw[ch], w1 = cw[768 + ch], w2 = cw[1536 + ch], bs = cb[ch];
#pragma unroll
    for (int i = 0; i < 4; ++i) { int t = lane + 64 * i; vv[i] = hy_zc(zs + ch, t, 256, w0, w1, w2, bs); U[t] = vv[i]; }
  }
  for (int o = 0; o < 2; ++o) {
    float s = 0.f;
    if (lane < 16) s = psum[(lane & 7) * 1024 + o * 512 + (lane >> 3) * 256 + ch];
    s = warp_sum(s);
    const float inv = 1.f / s;
    const u16* tf = taps + (size_t)(o * 512 + ch) * 256;
    const u16* tb = taps + (size_t)(o * 512 + 256 + ch) * 256;
    for (int idx = lane; idx < 512; idx += 64) {
      int off = idx - 255; float v = 0.f;
      if (idx < 511) v = off >= 0 ? bf2f(tf[off]) : bf2f(tb[-off]);
      Hs[idx] = v * inv;
    }
    __syncthreads();
    float acc[4] = {0.f, 0.f, 0.f, 0.f};
    for (int sidx = 0; sidx < 256; ++sidx) {
      float uu = U[sidx];
#pragma unroll
      for (int i = 0; i < 4; ++i) acc[i] += Hs[lane + 64 * i - sidx + 255] * uu;
    }
    const int gcol = o == 0 ? 256 + ch : 512 + ch;
    const float w0 = cw[gcol], w1 = cw[768 + gcol], w2 = cw[1536 + gcol], bs = cb[gcol];
    const float hb = p.in(22)[(l * 2 + o) * 256 + ch];
    float res[4];
#pragma unroll
    for (int i = 0; i < 4; ++i) {
      int t = lane + 64 * i;
      float xg = hy_zc(zs + gcol, t, 256, w0, w1, w2, bs);
      res[i] = xg * (acc[i] + hb * vv[i]);
    }
    __syncthreads();
    if (o == 0) {
#pragma unroll
      for (int i = 0; i < 4; ++i) { U[lane + 64 * i] = res[i]; vv[i] = res[i]; }
    } else {
#pragma unroll
      for (int i = 0; i < 4; ++i) {
        size_t tok = b * 256 + lane + 64 * i;
        float gv = bf2f(z[tok * ZW + 2560 + ch]);
        ybf[tok * 1024 + ch] = f2bf(res[i] * silu_f(gv));
      }
    }
    __syncthreads();
  }
}

__device__ __forceinline__ int s5_tokbase(int ss, int col) {
  if (ss < 2) return 8192 + ss * 4096 + 32 * col;
  return (16 * (ss - 2) + (col >> 3)) * 256 + 32 * (col & 7);
}

__device__ __forceinline__ void s5_item(const Params& p, int l, int item) {
  const int TIDX = opq_v(threadIdx.x);
  const int g = item >> 2, ss = item & 3;
  const int lg = l * 16 + g;
  const u16* z = (const u16*)(p.ws() + OFF_Z);
  const u16* E = (const u16*)(p.ws() + OFF_S5E) + (size_t)lg * 256 * 512;
  const u16* G = (const u16*)(p.ws() + OFF_S5G) + (size_t)lg * 512 * 256;
  const u16* KK = (const u16*)(p.ws() + OFF_S5KK) + (size_t)lg * 2 * 8192;
  float* Eu = (float*)(p.ws() + OFF_EU) + (size_t)item * 256 * 128;
  u16* Sin = (u16*)(p.ws() + OFF_SIN) + (size_t)item * 128 * 256;
  u16* yg = (u16*)(p.ws() + OFF_YG);
  const int tid = TIDX, lane = tid & 63, wid = tid >> 6, r = lane & 31, h = lane >> 5;
  const int col = wid * 32 + r;
  const int tb = s5_tokbase(ss, col);
  const u16* ub = z + (size_t)tb * ZW + 2304 + g * 16 + 8 * h;
  for (int half = 0; half < 2; ++half) {
    f32x16 acc[4];
#pragma unroll
    for (int a = 0; a < 4; ++a)
#pragma unroll
      for (int i = 0; i < 16; ++i) acc[a][i] = 0.f;
    for (int j = 0; j < 32; ++j) {
      bf16x8 uf = ld16(ub + (size_t)j * ZW);
#pragma unroll
      for (int rt = 0; rt < 4; ++rt) {
        bf16x8 ef = ld16(E + (size_t)(half * 128 + rt * 32 + r) * 512 + j * 16 + 8 * h);
        acc[rt] = mfma32(ef, uf, acc[rt]);
      }
    }
#pragma unroll
    for (int rt = 0; rt < 4; ++rt)
#pragma unroll
      for (int i = 0; i < 16; ++i) {
        int row = half * 128 + rt * 32 + (i & 3) + 8 * (i >> 2) + 4 * h;
        Eu[row * 128 + col] = acc[rt][i];
      }
  }
  __syncthreads();
  if (ss < 2) {
    if (tid < 128) {
      int dir = tid >> 6, pp = tid & 63;
      int base = (l * 2 + dir) * 16 + g;
      float dt = expf(p.in(26)[base]);
      float ar = p.in(24)[base * 64 + pp], ai = p.in(25)[base * 64 + pp];
      float mag = expf(ar * dt * 32.f);
      double tw = (double)(ai * dt) * 32.0 * 0.15915494309189535; tw -= floor(tw);
      float sn, cs; sincosf((float)(tw * 6.283185307179586), &sn, &cs);
      float lr = mag * cs, li = mag * sn;
      size_t sidx = ((size_t)((ss * 2 + l) * 2 + dir) * 16 + g) * 64 + pp;
      float sr = p.in(4)[sidx], si = p.in(5)[sidx];
      const float* er = Eu + (dir * 128 + pp) * 128; const float* ei = er + 64 * 128;
#pragma unroll 4
      for (int c4 = 0; c4 < 32; ++c4) {
        const int cb = dir == 0 ? c4 * 4 : 124 - c4 * 4;
        const float4 vr = *(const float4*)(er + cb), vi = *(const float4*)(ei + cb);
        const float rr[4] = {vr.x, vr.y, vr.z, vr.w}, ii[4] = {vi.x, vi.y, vi.z, vi.w};
#pragma unroll
        for (int q = 0; q < 4; ++q) {
          const int k = dir == 0 ? q : 3 - q;
          const int c2 = cb + k;
          Sin[c2 * 256 + dir * 128 + pp] = f2bf(sr); Sin[c2 * 256 + dir * 128 + 64 + pp] = f2bf(si);
          const float er_ = dir == 0 ? rr[q] : rr[3 - q], ei_ = dir == 0 ? ii[q] : ii[3 - q];
          float nr = lr * sr - li * si + er_, ni = lr * si + li * sr + ei_;
          sr = nr; si = ni;
        }
      }
    }
  } else {
    for (int e = tid; e < 2048; e += 256) {
      int sq = e >> 7, dir = (e >> 6) & 1, pp = e & 63;
      int base = (l * 2 + dir) * 16 + g;
      float dt = expf(p.in(26)[base]);
      float ar = p.in(24)[base * 64 + pp], ai = p.in(25)[base * 64 + pp];
      float mag = expf(ar * dt * 32.f);
      double tw = (double)(ai * dt) * 32.0 * 0.15915494309189535; tw -= floor(tw);
      float sn, cs; sincosf((float)(tw * 6.283185307179586), &sn, &cs);
      float lr = mag * cs, li = mag * sn;
      float sr = 0.f, si = 0.f;
      const float* er = Eu + (dir * 128 + pp) * 128; const float* ei = er + 64 * 128;
      for (int cc = 0; cc < 8; ++cc) {
        int c2 = sq * 8 + (dir == 0 ? cc : 7 - cc);
        Sin[c2 * 256 + dir * 128 + pp] = f2bf(sr); Sin[c2 * 256 + dir * 128 + 64 + pp] = f2bf(si);
        float nr = lr * sr - li * si + er[c2], ni = lr * si + li * sr + ei[c2];
        sr = nr; si = ni;
      }
      int bq = 16 * (ss - 2) + sq;
      size_t oidx = ((size_t)((bq * 2 + l) * 2 + dir) * 16 + g) * 64 + pp;
      p.out()[OUT_SRE + oidx] = sr; p.out()[OUT_SIM + oidx] = si;
    }
  }
  __syncthreads();
  const float* dsk = p.in(31) + l * 256 + g * 16;
  for (int rg = 0; rg < 4; ++rg) {
    f32x16 acc[4];
#pragma unroll
    for (int a = 0; a < 4; ++a)
#pragma unroll
      for (int i = 0; i < 16; ++i) acc[a][i] = 0.f;
    for (int j = 0; j < 32; ++j) {
      bf16x8 uf = ld16(ub + (size_t)j * ZW);
#pragma unroll
      for (int rt = 0; rt < 4; ++rt) {
        int i = 2 * (rg * 4 + rt) + (r >> 4), c = r & 15;
        int m = i - j;
        if (j <= 2 * (rg * 4 + rt) + 1) {
          bf16x8 f = zero8();
          if (m >= 0) f = ld16(KK + (size_t)m * 256 + c * 16 + 8 * h);
          acc[rt] = mfma32(f, uf, acc[rt]);
        }
        if (j >= 2 * (rg * 4 + rt)) {
          bf16x8 f = zero8();
          if (m <= 0) f = ld16(KK + 8192 + (size_t)(-m) * 256 + c * 16 + 8 * h);
          acc[rt] = mfma32(f, uf, acc[rt]);
        }
      }
    }
    for (int ks = 0; ks < 16; ++ks) {
      bf16x8 sf = ld16(Sin + (size_t)col * 256 + ks * 16 + 8 * h);
#pragma unroll
      for (int rt = 0; rt < 4; ++rt) {
        bf16x8 gf = ld16(G + (size_t)((rg * 4 + rt) * 32 + r) * 256 + ks * 16 + 8 * h);
        acc[rt] = mfma32(gf, sf, acc[rt]);
      }
    }
#pragma unroll
    for (int rt = 0; rt < 4; ++rt)
#pragma unroll
      for (int q = 0; q < 4; ++q) {
        int i = 2 * (rg * 4 + rt) + (q >> 1);
        int c0 = 8 * (q & 1) + 4 * h;
        size_t tok = tb + i;
        u32x2 uu = *reinterpret_cast<const u32x2*>(z + tok * ZW + 2304 + g * 16 + c0);
        float uvals[4] = {bfl(uu[0]), bfh(uu[0]), bfl(uu[1]), bfh(uu[1])};
        float o[4];
#pragma unroll
        for (int e = 0; e < 4; ++e) {
          float y = acc[rt][4 * q + e] + dsk[c0 + e] * uvals[e];
          float t3 = 0.7978845608028654f * (y + 0.044715f * y * y * y);
          o[e] = 0.5f * y * (1.f + tanhf(t3));
        }
        u32x2 ov = {pack2(o[0], o[1]), pack2(o[2], o[3])};
        *reinterpret_cast<u32x2*>(yg + tok * 256 + g * 16 + c0) = ov;
      }
  }
  __syncthreads();
}

__device__ __forceinline__ void glu_item(const Params& p, int l, int item) {
  const int TIDX = opq_v(threadIdx.x);
  const u16* yg = (const u16*)(p.ws() + OFF_YG);
  const u16* gT = (const u16*)(p.ws() + OFF_GLUT) + (size_t)l * 65536;
  const u16* z = (const u16*)(p.ws() + OFF_Z);
  u16* ybf = (u16*)(p.ws() + OFF_HBF);
  const float* gb = p.in(33) + l * 256;
  const int lane = TIDX & 63, wid = TIDX >> 6, r = lane & 31, h = lane >> 5;
  const int tok = item * 32 + r;
  f32x16 acc[2];
#pragma unroll
  for (int a = 0; a < 2; ++a)
#pragma unroll
    for (int i = 0; i < 16; ++i) acc[a][i] = 0.f;
  for (int ks = 0; ks < 16; ++ks) {
    bf16x8 yf = ld16(yg + (size_t)tok * 256 + ks * 16 + 8 * h);
#pragma unroll
    for (int rt = 0; rt < 2; ++rt) {
      bf16x8 wf = ld16(gT + (size_t)(wid * 64 + rt * 32 + r) * 256 + ks * 16 + 8 * h);
      acc[rt] = mfma32(wf, yf, acc[rt]);
    }
  }
#pragma unroll
  for (int rt = 0; rt < 2; ++rt)
#pragma unroll
    for (int q = 0; q < 4; ++q) {
      int n0 = wid * 64 + rt * 32 + 8 * q + 4 * h;
      u32x2 yy = *reinterpret_cast<const u32x2*>(yg + (size_t)tok * 256 + n0);
      u32x2 gg = *reinterpret_cast<const u32x2*>(z + (size_t)tok * ZW + 2560 + 768 + n0);
      float yv[4] = {bfl(yy[0]), bfh(yy[0]), bfl(yy[1]), bfh(yy[1])};
      float gv[4] = {bfl(gg[0]), bfh(gg[0]), bfl(gg[1]), bfh(gg[1])};
      float o[4];
#pragma unroll
      for (int e = 0; e < 4; ++e) {
        float v = acc[rt][4 * q + e] + gb[n0 + e];
        o[e] = yv[e] / (1.f + __expf(-v)) * silu_f(gv[e]);
      }
      u32x2 ov = {pack2(o[0], o[1]), pack2(o[2], o[3])};
      *reinterpret_cast<u32x2*>(ybf + (size_t)tok * 1024 + 768 + n0) = ov;
    }
}

__device__ __forceinline__ void phase_mixers(const Params& p, int l, char* smem) {
  const int N_HL = 256, N_S5 = 64, N_AL = 512, N_AC = 256, N_HC = 2048;
  const int total = N_HL + N_S5 + N_AL + N_AC + N_HC;
  unsigned* ctr = (unsigned*)(p.ws() + OFF_CTR) + 64 * l;
  for (;;) {
    int i = next_item(ctr, smem);
    if (i >= total) break;
    if (i < N_HL) { hyena_lat_item(p, l, i, smem); continue; }
    i -= N_HL;
    if (i < N_S5) { s5_item(p, l, i); continue; }
    i -= N_S5;
    if (i < N_AL) { attn_lat_item(p, l, i); continue; }
    i -= N_AL;
    if (i < N_AC) { attn_ctx_item(p, i); continue; }
    i -= N_AC;
    hyena_ctx_item(p, l, i, smem);
  }
}

__global__ void __launch_bounds__(256, 2) fwd_megakernel(KArgs ka) {
  __shared__ __attribute__((aligned(16))) char smem[LDS_BYTES + 512];
  cg::grid_group grid = cg::this_grid();
  {
    unsigned long long* t = (unsigned long long*)(smem + LDS_BYTES);
    if (threadIdx.x == 0) {
#pragma unroll
      for (int i = 0; i < 35; ++i) t[i] = (unsigned long long)ka.in[i];
      t[35] = (unsigned long long)ka.out; t[36] = (unsigned long long)ka.ws;
    }
    __syncthreads();
  }
  Params p; p.tab = (const unsigned long long*)(smem + LDS_BYTES);
  phase0(p, (float*)smem);
  grid.sync();
  volatile LAS unsigned* xst = (volatile LAS unsigned*)(smem + LDS_BYTES + 480);
  if (threadIdx.x == 0) { xst[0] = 0u; xst[1] = 0u; }
  __syncthreads();
  XcdBarrier xb = xcd_barrier_post((unsigned*)(p.ws() + OFF_BAR), xst);
#pragma unroll 1
  for (int l0 = 0; l0 < 2; ++l0) {
    const int l = opq_s(l0);
    phase_prenorm(p, l);
    xcd_barrier(xb);
    phase_gemm_in(p, l, smem);
    xcd_barrier(xb);
    phase_mixers(p, l, smem);
    xcd_barrier(xb);
    for (int it = blockIdx.x; it < 512; it += gridDim.x) glu_item(p, l, it);
    xcd_barrier(xb);
    phase_gemm_out(p, l, smem);
    xcd_barrier(xb);
  }
  phase_finalnorm(p);
}

extern "C" void kernel_launch(void* const* d_in, const int* in_sizes, int n_in, void* d_out, int out_size, void* d_ws, size_t ws_size, hipStream_t stream) {
  static int grid_blocks = 0;
  if (!grid_blocks) {
    int dev = 0, cus = 0, per_cu = 0;
    hipGetDevice(&dev);
    hipDeviceGetAttribute(&cus, hipDeviceAttributeMultiprocessorCount, dev);
    hipOccupancyMaxActiveBlocksPerMultiprocessor(&per_cu, fwd_megakernel, 256, 0);
    if (per_cu > 4) per_cu = 4;
    grid_blocks = cus * per_cu;
  }
  KArgs p{};
  for (int i = 0; i < 35; ++i) p.in[i] = (const float*)d_in[i];
  p.out = (float*)d_out;
  p.ws = (char*)d_ws;
  void* args[] = {&p};
  hipError_t e = hipLaunchCooperativeKernel((void*)fwd_megakernel, dim3(grid_blocks), dim3(256), args, 0, stream);
  if (e != hipSuccess) fprintf(stderr, "cooperative launch failed: %s (grid %d)\n", hipGetErrorString(e), grid_blocks);
}
```

```cpp
#include <hip/hip_runtime.h>
#include <hip/hip_cooperative_groups.h>
#include <cstdio>
namespace cg = cooperative_groups;

typedef unsigned short u16;
using bf16x8 = __attribute__((ext_vector_type(8))) short;
using f32x4 = __attribute__((ext_vector_type(4))) float;
using f32x16 = __attribute__((ext_vector_type(16))) float;
using u32x4 = __attribute__((ext_vector_type(4))) unsigned;
using u32x2 = __attribute__((ext_vector_type(2))) unsigned;

struct KArgs { const float* in[35]; float* out; char* ws; };
struct Params {
  const unsigned long long* tab;
  __device__ __forceinline__ unsigned long long get(int i) const {
    unsigned long long v = tab[i];
    unsigned lo = __builtin_amdgcn_readfirstlane((unsigned)v), hi = __builtin_amdgcn_readfirstlane((unsigned)(v >> 32));
    return ((unsigned long long)hi << 32) | lo;
  }
  __device__ __forceinline__ const float* in(int i) const { return (const float*)(const __attribute__((address_space(1))) float*)get(i); }
  __device__ __forceinline__ float* out() const { return (float*)(__attribute__((address_space(1))) float*)get(35); }
  __device__ __forceinline__ char* ws() const { return (char*)(__attribute__((address_space(1))) char*)get(36); }
};

constexpr size_t OFF_MOD   = 0;
constexpr size_t OFF_WINT  = OFF_MOD   + 73728;
constexpr size_t OFF_WOUTT = OFF_WINT  + 14680064;
constexpr size_t OFF_GLUT  = OFF_WOUTT + 4194304;
constexpr size_t OFF_HBF   = OFF_GLUT  + 262144;
constexpr size_t OFF_Z     = OFF_HBF   + 33554432;
constexpr size_t OFF_ZHT   = OFF_Z     + 75497472;
constexpr size_t OFF_GHT   = OFF_ZHT   + 25165824;
constexpr size_t OFF_QROT  = OFF_GHT   + 8388608;
constexpr size_t OFF_VT    = OFF_QROT  + 8388608;
constexpr size_t OFF_TAPS  = OFF_VT    + 16777216;
constexpr size_t TAPS_LAYER = 8388608 + 524288;
constexpr size_t OFF_PSUM  = OFF_TAPS  + 2 * TAPS_LAYER;
constexpr size_t PSUM_LAYER = (128 + 8) * 1024 * 4;
constexpr size_t OFF_CKB   = OFF_PSUM  + 2 * PSUM_LAYER;
constexpr size_t OFF_CVT   = OFF_CKB   + 1048576;
constexpr size_t OFF_ROPE  = OFF_CVT   + 1048576;
constexpr size_t OFF_S5KK  = OFF_ROPE  + 8192;
constexpr size_t OFF_S5E   = OFF_S5KK  + 1048576;
constexpr size_t OFF_S5G   = OFF_S5E   + 8388608;
constexpr size_t OFF_YG    = OFF_S5G   + 8388608;
constexpr size_t OFF_EU    = OFF_YG    + 8388608;
constexpr size_t OFF_SIN   = OFF_EU    + 8388608;
constexpr size_t OFF_BAR   = OFF_SIN   + 4194304;
constexpr size_t OFF_CTR   = OFF_BAR   + 16384;
constexpr size_t WS_TOTAL  = OFF_CTR   + 4096;

constexpr int ZW = 2304, ZQ = 0, ZK = 512, ZS = 1024, ZG = 1280;
constexpr size_t OUT_K = 16777216, OUT_V = 25165824, OUT_SRE = 33554432, OUT_SIM = 33685504;
constexpr int LDS_BYTES = 40960;
#ifndef REP_P0
#define REP_P0 1
#endif
#ifndef REP_GIN
#define REP_GIN 1
#endif
#ifndef REP_HL
#define REP_HL 1
#endif
#ifndef REP_S5
#define REP_S5 1
#endif
#ifndef REP_AL
#define REP_AL 1
#endif
#ifndef REP_AC
#define REP_AC 1
#endif
#ifndef REP_HC
#define REP_HC 1
#endif
#ifndef REP_GOUT
#define REP_GOUT 1
#endif

__device__ __forceinline__ int opq_v(int x) { asm volatile("" : "+v"(x)); return x; }
__device__ __forceinline__ int opq_s(int x) { asm volatile("" : "+s"(x)); return x; }
__device__ __forceinline__ u16 f2bf(float f) { unsigned u = __float_as_uint(f); u += 0x7fffu + ((u >> 16) & 1u); return (u16)(u >> 16); }
__device__ __forceinline__ float bf2f(u16 h) { return __uint_as_float(((unsigned)h) << 16); }
__device__ __forceinline__ unsigned pack2(float a, float b) { return (unsigned)f2bf(a) | ((unsigned)f2bf(b) << 16); }
__device__ __forceinline__ float silu_f(float x) { return x / (1.f + __expf(-x)); }
__device__ __forceinline__ float warp_sum(float v) { for (int o = 32; o > 0; o >>= 1) v += __shfl_xor(v, o); return v; }
__device__ __forceinline__ f32x16 mfma32(bf16x8 a, bf16x8 b, f32x16 c) { return __builtin_amdgcn_mfma_f32_32x32x16_bf16(a, b, c, 0, 0, 0); }
__device__ __forceinline__ f32x4 mfma16(bf16x8 a, bf16x8 b, f32x4 c) { return __builtin_amdgcn_mfma_f32_16x16x32_bf16(a, b, c, 0, 0, 0); }
__device__ __forceinline__ bf16x8 ld16(const u16* p) { return *reinterpret_cast<const bf16x8*>(p); }
__device__ __forceinline__ bf16x8 zero8() { bf16x8 z = {0, 0, 0, 0, 0, 0, 0, 0}; return z; }
__device__ __forceinline__ float bfl(unsigned w) { return __uint_as_float(w << 16); }
__device__ __forceinline__ float bfh(unsigned w) { return __uint_as_float(w & 0xffff0000u); }

__device__ __forceinline__ const float* xrow(const Params& p, int l, int row) {
  if (l == 0) return row < 8192 ? p.in(0) + (size_t)row * 1024 : p.in(1) + (size_t)(row - 8192) * 1024;
  return p.out() + (size_t)row * 1024;
}
__device__ __forceinline__ int cond_of(int row) { return row < 8192 ? 0 : 1 + ((row - 8192) >> 12); }


#define XB_TMO      128
#define XB_XCNT(j)  (256  + 64 * (j))
#define XB_XSUB(j)  (1280 + 64 * (j))
#define XB_XGEN(j)  (2304 + 64 * (j))
#define XB_TOP      3328
#define XB_TOPGEN   3392
#define XCD_BAR_WORDS 3456
#define XB_SPIN_CAP (1u << 22)
#define LAS __attribute__((address_space(3)))
__device__ __forceinline__ unsigned xb_ld(unsigned* p)              { return __hip_atomic_load(p, __ATOMIC_RELAXED, __HIP_MEMORY_SCOPE_AGENT); }
__device__ __forceinline__ unsigned xb_add(unsigned* p, unsigned v) { return __hip_atomic_fetch_add(p, v, __ATOMIC_RELAXED, __HIP_MEMORY_SCOPE_AGENT); }
__device__ __forceinline__ unsigned xb_xcc_id() { return (unsigned)__builtin_amdgcn_s_getreg((3 << 11) | 20) & 0xFu; }
#define XB_SPIN(cond, bar) do { unsigned _sp = 0; while (cond) { __builtin_amdgcn_s_sleep(1); \
    if ((++_sp & 255u) == 0u) { if (xb_ld(&(bar)[XB_TMO])) break; if (_sp > XB_SPIN_CAP) { atomicAdd(&(bar)[XB_TMO], 1u); break; } } } } while (0)
struct XcdBarrier { unsigned* bar; unsigned x; volatile LAS unsigned* st; };
__device__ __forceinline__ XcdBarrier xcd_barrier_post(unsigned* bar, volatile LAS unsigned* st) {
    XcdBarrier b; b.bar = bar; b.x = xb_xcc_id(); b.st = st;
    if (threadIdx.x == 0) (void)xb_add(&bar[XB_XCNT(b.x)], 1u);
    return b;
}
__device__ __forceinline__ void xcd_barrier_complete(unsigned* bar, unsigned x, unsigned& nloc, unsigned& nx) {
    const unsigned G = gridDim.x * gridDim.y * gridDim.z;
    unsigned sum, cnt, mine, sp = 0u;
    for (;;) {
        sum = 0u; cnt = 0u; mine = 0u;
#pragma unroll
        for (unsigned j = 0; j < 16; ++j) { const unsigned c = xb_ld(&bar[XB_XCNT(j)]); sum += c; cnt += (c > 0u) ? 1u : 0u; mine = (j == x) ? c : mine; }
        if (sum == G) break;
        __builtin_amdgcn_s_sleep(1);
        if ((++sp & 255u) == 0u) { if (xb_ld(&bar[XB_TMO])) break; if (sp > XB_SPIN_CAP) { atomicAdd(&bar[XB_TMO], 1u); break; } }
    }
    nloc = mine > 0u ? mine : 1u; nx = cnt > 0u ? cnt : 1u;
}
__device__ __forceinline__ void xcd_barrier(const XcdBarrier& b) {
    asm volatile("s_waitcnt vmcnt(0)" ::: "memory");
    __syncthreads();
    if (threadIdx.x == 0) {
        unsigned* bar = b.bar;
        __builtin_amdgcn_s_waitcnt(0);
        unsigned nloc = b.st[0], nx = b.st[1];
        if (nloc == 0u) { xcd_barrier_complete(bar, b.x, nloc, nx); b.st[0] = nloc; b.st[1] = nx; }
        const unsigned old = xb_add(&bar[XB_XSUB(b.x)], 1u);
        const unsigned gen = old / nloc;
        if (old + 1u == (gen + 1u) * nloc) {
            __builtin_amdgcn_fence(__ATOMIC_RELEASE, "agent");
            asm volatile("s_waitcnt vmcnt(0)" ::: "memory");
            const unsigned og = xb_add(&bar[XB_TOP], 1u);
            const unsigned tg = og / nx;
            if (og + 1u == (tg + 1u) * nx) xb_add(&bar[XB_TOPGEN], 1u);
            else XB_SPIN(xb_ld(&bar[XB_TOPGEN]) == tg, bar);
            __builtin_amdgcn_fence(__ATOMIC_ACQUIRE, "agent");
            xb_add(&bar[XB_XGEN(b.x)], 1u);
            asm volatile("s_waitcnt vmcnt(0)" ::: "memory");
        } else {
            XB_SPIN(xb_ld(&bar[XB_XGEN(b.x)]) == gen, bar);
            __builtin_amdgcn_fence(__ATOMIC_ACQUIRE, "agent");
            asm volatile("s_waitcnt vmcnt(0)" ::: "memory");
        }
    }
    __syncthreads();
}
__device__ __forceinline__ int next_item(unsigned* ctr, char* smem) {
  volatile int* slot = (volatile int*)(smem + LDS_BYTES + 496);
  __syncthreads();
  if (threadIdx.x == 0) *slot = (int)xb_add(ctr, 1u);
  __syncthreads();
  return *slot;
}

__device__ __forceinline__ void p0_mod(const Params& p, int item, float* lds) {
  const int TIDX = opq_v(threadIdx.x);
  int l = item / 48, n0 = (item % 48) * 64;
  float* sl = lds;
  float* red = lds + 3072;
  const float* W = p.in(9) + (size_t)l * 1024 * 3072;
  const float* cc = p.in(6);
  const float* cx = p.in(7);
  for (int e = TIDX; e < 3072; e += 256) { float v = e < 1024 ? cx[e] : cc[e - 1024]; sl[e] = silu_f(v); }
  __syncthreads();
  const int cq = TIDX & 15, ks = TIDX >> 4;
  float acc[3][4];
#pragma unroll
  for (int a = 0; a < 3; ++a)
#pragma unroll
    for (int b = 0; b < 4; ++b) acc[a][b] = 0.f;
#pragma unroll 8
  for (int kk = 0; kk < 64; ++kk) {
    const int k = ks * 64 + kk;
    const float4 w = *(const float4*)(W + (size_t)k * 3072 + n0 + cq * 4);
#pragma unroll
    for (int a = 0; a < 3; ++a) {
      const float sv = sl[a * 1024 + k];
      acc[a][0] += sv * w.x; acc[a][1] += sv * w.y; acc[a][2] += sv * w.z; acc[a][3] += sv * w.w;
    }
  }
#pragma unroll
  for (int a = 0; a < 3; ++a)
#pragma unroll
    for (int b = 0; b < 4; ++b) red[(ks * 3 + a) * 64 + cq * 4 + b] = acc[a][b];
  __syncthreads();
  if (TIDX < 192) {
    int cnd = TIDX >> 6, col = TIDX & 63;
    float sum = 0;
    for (int q = 0; q < 16; ++q) sum += red[(q * 3 + cnd) * 64 + col];
    ((float*)(p.ws() + OFF_MOD))[(l * 3 + cnd) * 3072 + n0 + col] = sum + p.in(10)[l * 3072 + n0 + col];
  }
  __syncthreads();
}

__device__ __forceinline__ void p0_tr(const float* src, int ldsrc, u16* dst, int lddst, int k0, int n0, float* lds) {
  const int TIDX = opq_v(threadIdx.x);
  for (int e = TIDX; e < 4096; e += 256) { int kk = e >> 6, nn = e & 63; lds[kk * 65 + nn] = src[(size_t)(k0 + kk) * ldsrc + n0 + nn]; }
  __syncthreads();
  for (int e = TIDX; e < 4096; e += 256) { int nn = e >> 6, kk = e & 63; dst[(size_t)(n0 + nn) * lddst + k0 + kk] = f2bf(lds[kk * 65 + nn]); }
  __syncthreads();
}

__device__ __forceinline__ void p0_filter(const Params& p, int l, int lsel, int chunk, float* lds) {
  const int TIDX = opq_v(threadIdx.x);
  const int L = lsel ? 4096 : 256;
  const int t0 = chunk * 32;
  float* feat = lds;
  float* h1 = lds + 1056;
  float* h2 = h1 + 2048;
  const float* w1 = p.in(15) + l * 33 * 64; const float* b1 = p.in(16) + l * 64;
  const float* w2 = p.in(17) + l * 64 * 64; const float* b2 = p.in(18) + l * 64;
  const float* fq = p.in(19) + l * 64;
  const float* w3 = p.in(20) + (size_t)l * 64 * 1024;
  const float* dec = p.in(21) + l * 1024;
  for (int e = TIDX; e < 32 * 33; e += 256) {
    int r = e / 33, f = e % 33; int ti = t0 + r; float v;
    if (f == 0) v = (float)ti / (float)L;
    else {
      int band = f <= 16 ? f : f - 16;
      int rem = (ti * band) % L;
      float ang = 6.283185307179586f * ((float)rem / (float)L);
      v = f <= 16 ? cosf(ang) : sinf(ang);
    }
    feat[e] = v;
  }
  __syncthreads();
  for (int e = TIDX; e < 2048; e += 256) {
    int r = e >> 6, j = e & 63; float s = b1[j];
    for (int f = 0; f < 33; ++f) s += feat[r * 33 + f] * w1[f * 64 + j];
    h1[e] = sinf(fq[j] * s);
  }
  __syncthreads();
  for (int e = TIDX; e < 2048; e += 256) {
    int r = e >> 6, j = e & 63; float s = b2[j];
    for (int k = 0; k < 64; ++k) s += h1[r * 64 + k] * w2[k * 64 + j];
    h2[e] = sinf(fq[j] * s);
  }
  __syncthreads();
  u16* taps = (u16*)(p.ws() + OFF_TAPS + l * TAPS_LAYER + (lsel ? 0 : 8388608));
  float* psum = (float*)(p.ws() + OFF_PSUM + l * PSUM_LAYER) + (lsel ? 0 : 128 * 1024) + chunk * 1024;
  for (int q = 0; q < 4; ++q) {
    int col = q * 256 + TIDX;
    float ad = fabsf(dec[col]);
    bool isb = (col & 256) != 0;
    float asum = 0;
    for (int r8 = 0; r8 < 4; ++r8) {
      float res[8];
#pragma unroll
      for (int rr = 0; rr < 8; ++rr) res[rr] = 0.f;
#pragma unroll 4
      for (int k = 0; k < 64; k += 4) {
        const float wa = w3[k * 1024 + col], wb = w3[(k + 1) * 1024 + col], wc = w3[(k + 2) * 1024 + col], wd = w3[(k + 3) * 1024 + col];
#pragma unroll
        for (int rr = 0; rr < 8; ++rr) {
          const float4 hv = *(const float4*)(h2 + (r8 * 8 + rr) * 64 + k);
          res[rr] += hv.x * wa + hv.y * wb + hv.z * wc + hv.w * wd;
        }
      }
      unsigned pk[4];
#pragma unroll
      for (int rr = 0; rr < 8; ++rr) {
        int ti = t0 + r8 * 8 + rr;
        float sv = res[rr] * __expf(-((float)ti / (float)L) * ad);
        if (!(isb && ti == 0)) asum += fabsf(sv);
        u16 hb = f2bf(sv);
        if (rr & 1) pk[rr >> 1] |= ((unsigned)hb) << 16; else pk[rr >> 1] = hb;
      }
      u32x4 v = {pk[0], pk[1], pk[2], pk[3]};
      *reinterpret_cast<u32x4*>(taps + (size_t)col * L + t0 + r8 * 8) = v;
    }
    psum[col] = asum;
  }
  __syncthreads();
}

__device__ __forceinline__ void p0_s5(const Params& p, int l, int g, int dir, int part, float* lds) {
  const int TIDX = opq_v(threadIdx.x);
  float2* pw = (float2*)lds;
  float2* bb = pw + 33 * 64;
  float2* cm = bb + 1024;
  const int base = ((l * 2 + dir) * 16 + g);
  const float dt = expf(p.in(26)[base]);
  const int tid = TIDX;
  for (int e = tid; e < 33 * 64; e += 256) {
    int m = e >> 6, pp = e & 63;
    float ar = p.in(24)[base * 64 + pp], ai = p.in(25)[base * 64 + pp];
    float mag = expf(ar * dt * (float)m);
    float ang = ai * dt;
    double angm = (double)ang * (double)m;
    double tw = angm * 0.15915494309189535;
    tw -= floor(tw);
    float a = (float)(tw * 6.283185307179586);
    float sn, cs; sincosf(a, &sn, &cs);
    pw[e] = make_float2(mag * cs, mag * sn);
  }
  for (int e = tid; e < 1024; e += 256) {
    int pp = e >> 4, c = e & 15;
    float ar = p.in(24)[base * 64 + pp], ai = p.in(25)[base * 64 + pp];
    float mag = expf(ar * dt); float sn, cs; sincosf(ai * dt, &sn, &cs);
    float nr = mag * cs - 1.f, ni = mag * sn;
    float den = ar * ar + ai * ai;
    float qr = (nr * ar + ni * ai) / den, qi = (ni * ar - nr * ai) / den;
    float br = p.in(27)[(size_t)base * 1024 + e], bi = p.in(28)[(size_t)base * 1024 + e];
    bb[e] = make_float2(qr * br - qi * bi, qr * bi + qi * br);
    int c2 = e >> 6, p2 = e & 63;
    cm[e] = make_float2(p.in(29)[(size_t)base * 1024 + c2 * 64 + p2], p.in(30)[(size_t)base * 1024 + c2 * 64 + p2]);
  }
  __syncthreads();
  const int lg = l * 16 + g;
  u16* KK = (u16*)(p.ws() + OFF_S5KK) + (size_t)lg * 2 * 8192;
  for (int e = part * 2048 + tid; e < part * 2048 + 2048; e += 256) {
    int m = e >> 8, c = (e >> 4) & 15, c2 = e & 15;
    if (m == 0) continue;
    float s = 0;
    for (int pp = 0; pp < 64; ++pp) {
      float2 C = cm[c * 64 + pp], W = pw[m * 64 + pp], B = bb[pp * 16 + c2];
      float tr = C.x * W.x - C.y * W.y, ti = C.x * W.y + C.y * W.x;
      s += tr * B.x - ti * B.y;
    }
    KK[(size_t)(dir == 0 ? 31 + m : 31 - m) * 256 + c * 16 + c2] = f2bf(s);
  }
  u16* E = (u16*)(p.ws() + OFF_S5E) + (size_t)lg * 256 * 512;
  for (int e = part * 8192 + tid; e < part * 8192 + 8192; e += 256) {
    int pp = e >> 9, k = e & 511, j = k >> 4, c2 = k & 15;
    float2 W = pw[(dir == 0 ? 31 - j : j) * 64 + pp], B = bb[pp * 16 + c2];
    float vr = W.x * B.x - W.y * B.y, vi = W.x * B.y + W.y * B.x;
    E[(size_t)(dir * 128 + pp) * 512 + k] = f2bf(vr);
    E[(size_t)(dir * 128 + 64 + pp) * 512 + k] = f2bf(vi);
  }
  u16* G = (u16*)(p.ws() + OFF_S5G) + (size_t)lg * 512 * 256;
  for (int e = part * 8192 + tid; e < part * 8192 + 8192; e += 256) {
    int row = e >> 6, pp = e & 63, i = row >> 4, c = row & 15;
    float2 C = cm[c * 64 + pp], W = pw[(dir == 0 ? i + 1 : 32 - i) * 64 + pp];
    float tr = C.x * W.x - C.y * W.y, ti = C.x * W.y + C.y * W.x;
    G[(size_t)row * 256 + dir * 128 + pp] = f2bf(tr);
    G[(size_t)row * 256 + dir * 128 + 64 + pp] = f2bf(-ti);
  }
  __syncthreads();
}

__device__ __forceinline__ void p0_s5_center(const Params& p, int l, int g, float* lds) {
  const int TIDX = opq_v(threadIdx.x);
  float2* qq = (float2*)lds;
  if (TIDX < 128) {
    int dir = TIDX >> 6, pp = TIDX & 63;
    int base = (l * 2 + dir) * 16 + g;
    float dt = expf(p.in(26)[base]);
    float ar = p.in(24)[base * 64 + pp], ai = p.in(25)[base * 64 + pp];
    float mag = expf(ar * dt); float sn, cs; sincosf(ai * dt, &sn, &cs);
    float nr = mag * cs - 1.f, ni = mag * sn;
    float den = ar * ar + ai * ai;
    qq[TIDX] = make_float2((nr * ar + ni * ai) / den, (ni * ar - nr * ai) / den);
  }
  __syncthreads();
  const int c = TIDX >> 4, c2 = TIDX & 15;
  float s = 0;
  for (int dir = 0; dir < 2; ++dir) {
    size_t base = (size_t)((l * 2 + dir) * 16 + g) * 1024;
    for (int pp = 0; pp < 64; ++pp) {
      float2 q = qq[dir * 64 + pp];
      float br = p.in(27)[base + pp * 16 + c2], bi = p.in(28)[base + pp * 16 + c2];
      float Br = q.x * br - q.y * bi, Bi = q.x * bi + q.y * br;
      float Cr = p.in(29)[base + c * 64 + pp], Ci = p.in(30)[base + c * 64 + pp];
      s += Cr * Br - Ci * Bi;
    }
  }
  u16* KK = (u16*)(p.ws() + OFF_S5KK) + (size_t)(l * 16 + g) * 2 * 8192;
  KK[31 * 256 + c * 16 + c2] = f2bf(s);
  __syncthreads();
}

__device__ __forceinline__ void p0_cache(const Params& p, int item) {
  const int TIDX = opq_v(threadIdx.x);
  int l = item >> 4, b = (item >> 3) & 1, h = item & 7;
  const float* ck = p.in(2) + ((size_t)((b * 2 + l) * 8 + h)) * 16384;
  const float* cv = p.in(3) + ((size_t)((b * 2 + l) * 8 + h)) * 16384;
  u16* ok = (u16*)(p.ws() + OFF_CKB) + (size_t)item * 16384;
  u16* ov = (u16*)(p.ws() + OFF_CVT) + (size_t)item * 16384;
  for (int e = TIDX; e < 16384; e += 256) {
    ok[e] = f2bf(ck[e]);
    int d = e >> 8, key = e & 255;
    ov[e] = f2bf(cv[key * 64 + d]);
  }
}

__device__ __forceinline__ void phase0(const Params& p, float* lds) {
  const int TIDX = opq_v(threadIdx.x);
  const int BIDX = opq_s(blockIdx.x);
  const int N_FILT = 272, N_S5 = 256, N_MOD = 96, N_WIN = 1792, N_WOUT = 512, N_GLU = 32, N_CACHE = 32, N_S5C = 32, N_ROPE = 1;
  const int total = N_FILT + N_S5 + N_MOD + N_WIN + N_WOUT + N_GLU + N_CACHE + N_S5C + N_ROPE;
  if (BIDX == 0) { unsigned* bz = (unsigned*)(p.ws() + OFF_BAR); for (int e = TIDX; e < (16384 + 4096) / 4; e += 256) bz[e] = 0u; }
  for (int it = BIDX; it < total; it += gridDim.x) {
    int i = it;
    if (i < N_FILT) {
      int l = i / 136, r = i % 136;
      if (r < 128) p0_filter(p, l, 1, r, lds); else p0_filter(p, l, 0, r - 128, lds);
      continue;
    }
    i -= N_FILT;
    if (i < N_S5) { p0_s5(p, i >> 7, (i >> 3) & 15, (i >> 2) & 1, i & 3, lds); continue; }
    i -= N_S5;
    if (i < N_MOD) { p0_mod(p, i, lds); continue; }
    i -= N_MOD;
    if (i < N_WIN) {
      int l = i / 896, r = i % 896;
      p0_tr(p.in(11) + (size_t)l * 1024 * 3584, 3584, (u16*)(p.ws() + OFF_WINT) + (size_t)l * 3584 * 1024, 1024, (r / 56) * 64, (r % 56) * 64, lds);
      continue;
    }
    i -= N_WIN;
    if (i < N_WOUT) {
      int l = i >> 8, r = i & 255;
      p0_tr(p.in(12) + (size_t)l * 1024 * 1024, 1024, (u16*)(p.ws() + OFF_WOUTT) + (size_t)l * 1024 * 1024, 1024, (r >> 4) * 64, (r & 15) * 64, lds);
      continue;
    }
    i -= N_WOUT;
    if (i < N_GLU) {
      int l = i >> 4, r = i & 15;
      p0_tr(p.in(32) + (size_t)l * 65536, 256, (u16*)(p.ws() + OFF_GLUT) + (size_t)l * 65536, 256, (r >> 2) * 64, (r & 3) * 64, lds);
      continue;
    }
    i -= N_GLU;
    if (i < N_CACHE) { p0_cache(p, i); continue; }
    i -= N_CACHE;
    if (i < N_S5C) { p0_s5_center(p, i >> 4, i & 15, lds); continue; }
    float2* tab = (float2*)(p.ws() + OFF_ROPE);
    for (int e = TIDX; e < 1024; e += 256) {
      int pos = e >> 4, k = e & 15;
      float inv = expf(-(float)k * (9.210340371976184f / 16.f));
      float sn, cs; sincosf((float)pos * inv, &sn, &cs);
      tab[e] = make_float2(cs, sn);
    }
  }
}

__device__ __forceinline__ void phase_prenorm(const Params& p, int l) {
  const int TIDX = opq_v(threadIdx.x);
  const int BIDX = opq_s(blockIdx.x);
  const float* mod = (const float*)(p.ws() + OFF_MOD) + l * 3 * 3072;
  const float* ng = p.in(8) + l * 1024;
  u16* hbf = (u16*)(p.ws() + OFF_HBF);
  int wave = TIDX >> 6, lane = TIDX & 63;
  for (int row = BIDX * 4 + wave; row < 16384; row += gridDim.x * 4) {
    const float* x = xrow(p, l, row);
    const float* md = mod + cond_of(row) * 3072;
    float4 v[4]; float ss = 0;
#pragma unroll
    for (int i = 0; i < 4; ++i) { v[i] = *(const float4*)(x + i * 256 + lane * 4); ss += v[i].x * v[i].x + v[i].y * v[i].y + v[i].z * v[i].z + v[i].w * v[i].w; }
    ss = warp_sum(ss);
    float rstd = rsqrtf(ss * (1.f / 1024.f) + 1e-6f);
#pragma unroll
    for (int i = 0; i < 4; ++i) {
      int col = i * 256 + lane * 4;
      float4 g = *(const float4*)(ng + col), sh = *(const float4*)(md + col), sc = *(const float4*)(md + 1024 + col);
      float h0 = v[i].x * rstd * g.x * (1.f + sc.x) + sh.x;
      float h1 = v[i].y * rstd * g.y * (1.f + sc.y) + sh.y;
      float h2 = v[i].z * rstd * g.z * (1.f + sc.z) + sh.z;
      float h3 = v[i].w * rstd * g.w * (1.f + sc.w) + sh.w;
      u32x2 o = {pack2(h0, h1), pack2(h2, h3)};
      *reinterpret_cast<u32x2*>(hbf + (size_t)row * 1024 + col) = o;
    }
  }
}

__device__ __forceinline__ void phase_finalnorm(const Params& p) {
  const int TIDX = opq_v(threadIdx.x);
  const int BIDX = opq_s(blockIdx.x);
  const float* ng = p.in(34);
  int wave = TIDX >> 6, lane = TIDX & 63;
  for (int row = BIDX * 4 + wave; row < 16384; row += gridDim.x * 4) {
    float* x = p.out() + (size_t)row * 1024;
    float4 v[4]; float ss = 0;
#pragma unroll
    for (int i = 0; i < 4; ++i) { v[i] = *(const float4*)(x + i * 256 + lane * 4); ss += v[i].x * v[i].x + v[i].y * v[i].y + v[i].z * v[i].z + v[i].w * v[i].w; }
    ss = warp_sum(ss);
    float rstd = rsqrtf(ss * (1.f / 1024.f) + 1e-6f);
#pragma unroll
    for (int i = 0; i < 4; ++i) {
      int col = i * 256 + lane * 4;
      float4 g = *(const float4*)(ng + col);
      float4 o = make_float4(v[i].x * rstd * g.x, v[i].y * rstd * g.y, v[i].z * rstd * g.z, v[i].w * rstd * g.w);
      *(float4*)(x + col) = o;
    }
  }
}

template <bool SWAP, class FA, class FB>
__device__ __forceinline__ void gemm_mainloop_g(FA fa, FB fb, int nk, char* smem, f32x4 (&acc)[4][4]) {
  const int tid = opq_v(threadIdx.x), lane = tid & 63, wid = tid >> 6, wm = wid >> 1, wn = wid & 1, fr = lane & 15, fq = lane >> 4;
  char* sA = smem; char* sB = smem + 16384;
  for (int kt = 0; kt < nk; ++kt) {
#pragma unroll
    for (int i = 0; i < 4; ++i) {
      int pch = i * 256 + tid; int r = pch >> 3, cp = pch & 7; int c = cp ^ ((r >> 1) & 7);
      __builtin_amdgcn_global_load_lds((const unsigned*)fa(r, kt, c), (__attribute__((address_space(3))) unsigned*)(sA + pch * 16), 16, 0, 0);
      __builtin_amdgcn_global_load_lds((const unsigned*)fb(r, kt, c), (__attribute__((address_space(3))) unsigned*)(sB + pch * 16), 16, 0, 0);
    }
    __syncthreads();
#pragma unroll
    for (int ks = 0; ks < 2; ++ks) {
      bf16x8 xa[4], wb[4];
#pragma unroll
      for (int t = 0; t < 4; ++t) {
        int c = ks * 4 + fq;
        int r = wm * 64 + t * 16 + fr;
        xa[t] = *(const bf16x8*)(sA + (r * 8 + (c ^ ((r >> 1) & 7))) * 16);
        int rn = wn * 64 + t * 16 + fr;
        wb[t] = *(const bf16x8*)(sB + (rn * 8 + (c ^ ((rn >> 1) & 7))) * 16);
      }
#pragma unroll
      for (int mt = 0; mt < 4; ++mt)
#pragma unroll
        for (int nt = 0; nt < 4; ++nt)
          acc[mt][nt] = SWAP ? mfma16(wb[nt], xa[mt], acc[mt][nt]) : mfma16(xa[mt], wb[nt], acc[mt][nt]);
    }
    __syncthreads();
  }
}

template <bool SWAP>
__device__ __forceinline__ void gemm_mainloop(const u16* __restrict__ A, const u16* __restrict__ Bt, int m0, int n0, char* smem, f32x4 (&acc)[4][4]) {
  auto fa = [=](int r, int kt, int c) { return A + (size_t)(m0 + r) * 1024 + kt * 64 + c * 8; };
  auto fb = [=](int r, int kt, int c) { return Bt + (size_t)(n0 + r) * 1024 + kt * 64 + c * 8; };
  gemm_mainloop_g<SWAP>(fa, fb, 16, smem, acc);
}

__device__ __forceinline__ void phase_gemm_in(const Params& p, int l, char* smem) {
  const int TIDX = opq_v(threadIdx.x);
  const int BIDX = opq_s(blockIdx.x);
  const u16* A = (const u16*)(p.ws() + OFF_HBF);
  const u16* Bt = (const u16*)(p.ws() + OFF_WINT) + (size_t)l * 3584 * 1024;
  u16* z = (u16*)(p.ws() + OFF_Z);
  u16* qrot = (u16*)(p.ws() + OFF_QROT);
  u16* vT = (u16*)(p.ws() + OFF_VT);
  const float2* tab = (const float2*)(p.ws() + OFF_ROPE);
  const int lane = TIDX & 63, wid = TIDX >> 6, wm = wid >> 1, wn = wid & 1, fr = lane & 15, fq = lane >> 4;
  for (int tile = BIDX; tile < 128 * 28; tile += gridDim.x) {
    int m0 = (tile / 28) * 128, n0 = (tile % 28) * 128;
    f32x4 acc[4][4];
#pragma unroll
    for (int a = 0; a < 4; ++a)
#pragma unroll
      for (int b = 0; b < 4; ++b) acc[a][b] = f32x4{0.f, 0.f, 0.f, 0.f};
    const bool vtile = n0 >= 1792 && n0 < 2304;
    const bool ttile = vtile || n0 < 768 || (n0 >= 2560 && n0 < 2816);
    if (ttile) {
      u16* tb = vtile ? vT - (size_t)1792 * 16384 : (n0 < 768 ? (u16*)(p.ws() + OFF_ZHT) : (u16*)(p.ws() + OFF_GHT) - (size_t)2560 * 16384);
      gemm_mainloop<false>(A, Bt, m0, n0, smem, acc);
#pragma unroll
      for (int mt = 0; mt < 4; ++mt)
#pragma unroll
        for (int nt = 0; nt < 4; ++nt) {
          int m = m0 + wm * 64 + mt * 16 + fq * 4, n = n0 + wn * 64 + nt * 16 + fr;
          f32x4 v = acc[mt][nt];
          u32x2 o = {pack2(v[0], v[1]), pack2(v[2], v[3])};
          *reinterpret_cast<u32x2*>(tb + (size_t)n * 16384 + m) = o;
          n -= 1792;
          if (vtile && m0 < 8192) {
            int b = m >> 8, t = m & 255, head = n >> 6, d = n & 63;
            float* o2 = p.out() + OUT_V + ((size_t)((b * 2 + l) * 8 + head) * 256 + t) * 64 + d;
            o2[0] = v[0]; o2[64] = v[1]; o2[128] = v[2]; o2[192] = v[3];
          }
        }
    } else {
      gemm_mainloop<true>(A, Bt, m0, n0, smem, acc);
      const int nbase = n0 + wn * 64;
      const bool lat = m0 >= 8192;
      const bool isq = nbase >= 768 && nbase < 1280, isk = nbase >= 1280 && nbase < 1792;
      const int zbase = nbase < 1792 ? nbase - 768 : nbase - 1280;
#pragma unroll
      for (int mt = 0; mt < 4; ++mt) {
        int m = m0 + wm * 64 + mt * 16 + fr;
        if (!(lat && isk)) {
#pragma unroll
          for (int nt = 0; nt < 4; ++nt) {
            f32x4 v = acc[mt][nt];
            u32x2 o = {pack2(v[0], v[1]), pack2(v[2], v[3])};
            *reinterpret_cast<u32x2*>(z + (size_t)m * ZW + zbase + nt * 16 + fq * 4) = o;
          }
        }
        if (!lat && isk) {
          int b = m >> 8, t = m & 255, head = (nbase - 1280) >> 6;
          float* o2 = p.out() + OUT_K + ((size_t)((b * 2 + l) * 8 + head) * 256 + t) * 64 + fq * 4;
#pragma unroll
          for (int nt = 0; nt < 4; ++nt) *(float4*)(o2 + nt * 16) = make_float4(acc[mt][nt][0], acc[mt][nt][1], acc[mt][nt][2], acc[mt][nt][3]);
        }
        if (lat && (isq || isk)) {
          int ml = (m - 8192) & 4095; int prow = ml >> 6, pcol = ml & 63;
          f32x4 r[4];
#pragma unroll
          for (int j = 0; j < 4; ++j) {
            float2 a = tab[prow * 16 + fq * 4 + j], b = tab[pcol * 16 + fq * 4 + j];
            float x1 = acc[mt][0][j], x2 = acc[mt][1][j];
            r[0][j] = x1 * a.x - x2 * a.y; r[1][j] = x2 * a.x + x1 * a.y;
            x1 = acc[mt][2][j]; x2 = acc[mt][3][j];
            r[2][j] = x1 * b.x - x2 * b.y; r[3][j] = x2 * b.x + x1 * b.y;
          }
          u16* dst = isq ? qrot + (size_t)(m - 8192) * 512 + (nbase - 768) + fq * 4 : z + (size_t)m * ZW + zbase + fq * 4;
#pragma unroll
          for (int nt = 0; nt < 4; ++nt) {
            u32x2 o = {pack2(r[nt][0], r[nt][1]), pack2(r[nt][2], r[nt][3])};
            *reinterpret_cast<u32x2*>(dst + nt * 16) = o;
          }
        }
      }
    }
  }
}

__device__ __forceinline__ void phase_gemm_out(const Params& p, int l, char* smem) {
  const int TIDX = opq_v(threadIdx.x);
  const int BIDX = opq_s(blockIdx.x);
  const u16* A = (const u16*)(p.ws() + OFF_HBF);
  const u16* Bt = (const u16*)(p.ws() + OFF_WOUTT) + (size_t)l * 1024 * 1024;
  const float* mod = (const float*)(p.ws() + OFF_MOD) + l * 3 * 3072;
  const int lane = TIDX & 63, wid = TIDX >> 6, wm = wid >> 1, wn = wid & 1, fr = lane & 15, fq = lane >> 4;
  for (int tile = BIDX; tile < 128 * 8; tile += gridDim.x) {
    int m0 = (tile >> 3) * 128, n0 = (tile & 7) * 128;
    f32x4 acc[4][4];
#pragma unroll
    for (int a = 0; a < 4; ++a)
#pragma unroll
      for (int b = 0; b < 4; ++b) acc[a][b] = f32x4{0.f, 0.f, 0.f, 0.f};
    gemm_mainloop<true>(A, Bt, m0, n0, smem, acc);
#pragma unroll
    for (int mt = 0; mt < 4; ++mt) {
      int m = m0 + wm * 64 + mt * 16 + fr;
      const float* xr = xrow(p, l, m);
      const float* gate = mod + cond_of(m) * 3072 + 2048;
#pragma unroll
      for (int nt = 0; nt < 4; ++nt) {
        int n = n0 + wn * 64 + nt * 16 + fq * 4;
        float4 x = *(const float4*)(xr + n), g = *(const float4*)(gate + n);
        f32x4 v = acc[mt][nt];
        *(float4*)(p.out() + (size_t)m * 1024 + n) = make_float4(x.x + g.x * v[0], x.y + g.y * v[1], x.z + g.z * v[2], x.w + g.w * v[3]);
      }
    }
  }
}

struct AttState { float m, l; f32x16 o0, o1; };
struct KFrag { bf16x8 k[4]; };
struct VFrag { u32x2 v[8]; };

__device__ __forceinline__ void load_k(KFrag& f, const u16* kp) {
#pragma unroll
  for (int ks = 0; ks < 4; ++ks) f.k[ks] = ld16(kp + ks * 16);
}
__device__ __forceinline__ void load_v(VFrag& f, const u16* vt, size_t vstride, int lane) {
  const int d = lane & 31, h = lane >> 5;
#pragma unroll
  for (int dt = 0; dt < 2; ++dt)
#pragma unroll
    for (int sp = 0; sp < 2; ++sp) {
      const u16* v0 = vt + (size_t)(dt * 32 + d) * vstride + 16 * sp + 4 * h;
      f.v[(dt * 2 + sp) * 2] = *reinterpret_cast<const u32x2*>(v0);
      f.v[(dt * 2 + sp) * 2 + 1] = *reinterpret_cast<const u32x2*>(v0 + 8);
    }
}
__device__ __forceinline__ f32x16 qk_tile(const KFrag& kf, const bf16x8 (&qf)[4]) {
  f32x16 s;
#pragma unroll
  for (int i = 0; i < 16; ++i) s[i] = 0.f;
#pragma unroll
  for (int ks = 0; ks < 4; ++ks) s = mfma32(kf.k[ks], qf[ks], s);
  return s;
}

__device__ __forceinline__ void attn_tile(const f32x16& s, AttState& st, const VFrag& vf) {
  float mx = s[0];
#pragma unroll
  for (int i = 1; i < 16; ++i) mx = fmaxf(mx, s[i]);
  mx = fmaxf(mx, __shfl_xor(mx, 32));
  float mn = fmaxf(st.m, mx);
  float alpha = __expf(st.m - mn);
  float pv[16]; float ps = 0;
#pragma unroll
  for (int i = 0; i < 16; ++i) { pv[i] = __expf(s[i] - mn); ps += pv[i]; }
  st.l = st.l * alpha + ps; st.m = mn;
#pragma unroll
  for (int i = 0; i < 16; ++i) { st.o0[i] *= alpha; st.o1[i] *= alpha; }
#pragma unroll
  for (int sp = 0; sp < 2; ++sp) {
    u32x4 pw = {pack2(pv[8 * sp], pv[8 * sp + 1]), pack2(pv[8 * sp + 2], pv[8 * sp + 3]), pack2(pv[8 * sp + 4], pv[8 * sp + 5]), pack2(pv[8 * sp + 6], pv[8 * sp + 7])};
    bf16x8 pf = __builtin_bit_cast(bf16x8, pw);
    u32x4 va = {vf.v[sp * 2][0], vf.v[sp * 2][1], vf.v[sp * 2 + 1][0], vf.v[sp * 2 + 1][1]};
    st.o0 = mfma32(__builtin_bit_cast(bf16x8, va), pf, st.o0);
    u32x4 vb = {vf.v[(2 + sp) * 2][0], vf.v[(2 + sp) * 2][1], vf.v[(2 + sp) * 2 + 1][0], vf.v[(2 + sp) * 2 + 1][1]};
    st.o1 = mfma32(__builtin_bit_cast(bf16x8, vb), pf, st.o1);
  }
}

__device__ __forceinline__ void attn_finish(AttState& st, const u16* z, u16* ybf, int tok, int head, int lane) {
  float lt = st.l + __shfl_xor(st.l, 32);
  float inv = 1.f / lt;
  const int h = lane >> 5;
  u32x2 gg[8];
#pragma unroll
  for (int q = 0; q < 8; ++q) gg[q] = *reinterpret_cast<const u32x2*>(z + (size_t)tok * ZW + ZG + 256 + head * 64 + (q >> 2) * 32 + 8 * (q & 3) + 4 * h);
#pragma unroll
  for (int dt = 0; dt < 2; ++dt)
#pragma unroll
    for (int rg = 0; rg < 4; ++rg) {
      int d0 = dt * 32 + 8 * rg + 4 * h;
      u32x2 g2 = gg[dt * 4 + rg];
      float o[4];
#pragma unroll
      for (int i = 0; i < 4; ++i) o[i] = (dt ? st.o1[4 * rg + i] : st.o0[4 * rg + i]) * inv;
      o[0] *= silu_f(bfl(g2[0])); o[1] *= silu_f(bfh(g2[0])); o[2] *= silu_f(bfl(g2[1])); o[3] *= silu_f(bfh(g2[1]));
      u32x2 ov = {pack2(o[0], o[1]), pack2(o[2], o[3])};
      *reinterpret_cast<u32x2*>(ybf + (size_t)tok * 1024 + 256 + head * 64 + d0) = ov;
    }
}

__device__ __forceinline__ void attn_ctx_item(const Params& p, int item) {
  const int TIDX = opq_v(threadIdx.x);
  const int b = item >> 3, head = item & 7;
  const u16* z = (const u16*)(p.ws() + OFF_Z);
  const u16* vT = (const u16*)(p.ws() + OFF_VT);
  u16* ybf = (u16*)(p.ws() + OFF_HBF);
  const int lane = TIDX & 63, wid = TIDX >> 6, r = lane & 31, h = lane >> 5;
  const int tok0 = b * 256;
  const u16* kbase = z + (size_t)(tok0 + r) * ZW + ZK + head * 64 + 8 * h;
  const u16* vbase = vT + (size_t)(head * 64) * 16384 + tok0;
#pragma unroll 1
  for (int pass = 0; pass < 2; ++pass) {
    const int qt = wid + 4 * pass;
    const int qtok = tok0 + qt * 32 + r;
    bf16x8 qf[4];
#pragma unroll
    for (int ks = 0; ks < 4; ++ks) qf[ks] = ld16(z + (size_t)qtok * ZW + ZQ + head * 64 + ks * 16 + 8 * h);
    AttState st; st.m = -1e30f; st.l = 0.f;
#pragma unroll
    for (int i = 0; i < 16; ++i) { st.o0[i] = 0.f; st.o1[i] = 0.f; }
    KFrag kc, kn; VFrag vf;
    load_k(kc, kbase);
#pragma unroll 1
    for (int kt = 0; kt < 8; ++kt) {
      load_v(vf, vbase + kt * 32, 16384, lane);
      load_k(kn, kbase + (size_t)((kt + 1) & 7) * 32 * ZW);
      __builtin_amdgcn_sched_barrier(0);
      f32x16 s = qk_tile(kc, qf);
#pragma unroll
      for (int i = 0; i < 16; ++i) s[i] *= 0.125f;
      attn_tile(s, st, vf);
      kc = kn;
      __builtin_amdgcn_sched_barrier(0);
    }
    attn_finish(st, z, ybf, qtok, head, lane);
  }
}

__device__ __forceinline__ void attn_lat_item(const Params& p, int l, int item, char* smem) {
  const int TIDX = opq_v(threadIdx.x);
  const int b = item >> 8, head = (item >> 5) & 7, rp = item & 31;
  const u16* z = (const u16*)(p.ws() + OFF_Z);
  const u16* vT = (const u16*)(p.ws() + OFF_VT);
  const u16* qrot = (const u16*)(p.ws() + OFF_QROT);
  u16* ybf = (u16*)(p.ws() + OFF_HBF);
  const int lane = TIDX & 63, wid = TIDX >> 6, r = lane & 31, h = lane >> 5;
  float* rpl = (float*)smem;
  {
    const float* rpb = p.in(23) + (size_t)(l * 8 + head) * 15 * 31;
    for (int e = TIDX; e < 465; e += 256) rpl[e] = rpb[e];
    __syncthreads();
  }
  const int grow = rp * 2 + (wid >> 1), qt = wid & 1;
  const int qc = qt * 32 + r;
  const int ltok = b * 4096 + grow * 64 + qc;
  const int qtok = 8192 + ltok;
  AttState st; st.m = -1e30f; st.l = 0.f;
#pragma unroll
  for (int i = 0; i < 16; ++i) { st.o0[i] = 0.f; st.o1[i] = 0.f; }
  KFrag kc, kn; VFrag vf;
  int rs = grow - 4; rs = rs < 0 ? 0 : (rs > 56 ? 56 : rs);
  const u16* kwin = z + (size_t)(8192 + b * 4096 + rs * 64 + r) * ZW + ZK + head * 64 + 8 * h;
  const u16* vwin = vT + (size_t)(head * 64) * 16384 + 8192 + b * 4096 + rs * 64;
  {
    bf16x8 qf[4];
#pragma unroll
    for (int ks = 0; ks < 4; ++ks) qf[ks] = ld16(z + (size_t)qtok * ZW + ZQ + head * 64 + ks * 16 + 8 * h);
    const u16* ck = (const u16*)(p.ws() + OFF_CKB) + (size_t)((l * 2 + b) * 8 + head) * 16384 + (size_t)r * 64 + 8 * h;
    const u16* cv = (const u16*)(p.ws() + OFF_CVT) + (size_t)((l * 2 + b) * 8 + head) * 16384;
    load_k(kc, ck);
#pragma unroll 1
    for (int kt = 0; kt < 8; ++kt) {
      load_v(vf, cv + kt * 32, 256, lane);
      if (kt < 7) load_k(kn, ck + (size_t)(kt + 1) * 32 * 64); else load_k(kn, kwin);
      __builtin_amdgcn_sched_barrier(0);
      f32x16 s = qk_tile(kc, qf);
#pragma unroll
      for (int i = 0; i < 16; ++i) s[i] *= 0.125f;
      attn_tile(s, st, vf);
      kc = kn;
      __builtin_amdgcn_sched_barrier(0);
    }
  }
  {
    bf16x8 qf[4];
#pragma unroll
    for (int ks = 0; ks < 4; ++ks) qf[ks] = ld16(qrot + (size_t)ltok * 512 + head * 64 + ks * 16 + 8 * h);
    int cstart = qc - 8; cstart = cstart < 0 ? 0 : (cstart > 48 ? 48 : cstart);
#pragma unroll 1
    for (int t = 0; t < 16; ++t) {
      const int wi = t >> 1, hf = t & 1;
      load_v(vf, vwin + t * 32, 16384, lane);
      load_k(kn, kwin + (size_t)((t + 1) & 15) * 32 * ZW);
      __builtin_amdgcn_sched_barrier(0);
      f32x16 s = qk_tile(kc, qf);
      const float* rb = rpl + (rs + wi - grow + 7) * 31;
#pragma unroll
      for (int i = 0; i < 16; ++i) {
        int kcol = hf * 32 + (i & 3) + 8 * (i >> 2) + 4 * h;
        bool valid = kcol >= cstart && kcol < cstart + 16;
        int ci = kcol - qc + 15; ci = ci < 0 ? 0 : (ci > 30 ? 30 : ci);
        float bias = rb[ci];
        s[i] = valid ? s[i] * 0.125f + bias : -INFINITY;
      }
      attn_tile(s, st, vf);
      kc = kn;
      __builtin_amdgcn_sched_barrier(0);
    }
  }
  attn_finish(st, z, ybf, qtok, head, lane);
  __syncthreads();
}

__device__ __forceinline__ float hy_zc(const u16* zcol, int t, int L, float w0, float w1, float w2, float bias) {
  float a = bias + w1 * bf2f(zcol[t]);
  if (t > 0) a += w0 * bf2f(zcol[t - 1]);
  if (t < L - 1) a += w2 * bf2f(zcol[t + 1]);
  return a;
}

__device__ __forceinline__ void hyena_lat_item(const Params& p, int l, int ch, char* smem) {
  const int TIDX = opq_v(threadIdx.x);
  u16* Hs = (u16*)smem;
  u16* UR = (u16*)(smem + 18432);
  float* red = (float*)(smem + 18432 + 16960);
  const u16* zhT = (const u16*)(p.ws() + OFF_ZHT);
  const u16* ghT = (const u16*)(p.ws() + OFF_GHT);
  u16* ybf = (u16*)(p.ws() + OFF_HBF);
  const u16* taps = (const u16*)(p.ws() + OFF_TAPS + l * TAPS_LAYER);
  const float* psum = (const float*)(p.ws() + OFF_PSUM + l * PSUM_LAYER);
  const float* cw = p.in(13) + l * 3 * 768; const float* cb = p.in(14) + l * 768;
  const int tid = TIDX, lane = tid & 63, wid = tid >> 6;
  {
    int o = tid >> 7, idx = tid & 127;
    float s = psum[idx * 1024 + o * 512 + ch] + psum[idx * 1024 + o * 512 + 256 + ch];
    s = warp_sum(s);
    if (lane == 0) red[wid] = s;
  }
  {
    const float w0 = cw[ch], w1 = cw[768 + ch], w2 = cw[1536 + ch], bs = cb[ch];
    for (int cidx = tid; cidx < 2 * 530; cidx += 256) {
      const int b = cidx >= 530 ? 1 : 0, ci = cidx - b * 530;
      const int i0 = ci * 8, tlo = 4152 - i0;
      const u16* zr = zhT + (size_t)ch * 16384 + 8192 + b * 4096;
      u32x4 ov = {0u, 0u, 0u, 0u};
      if (tlo >= 0 && tlo <= 4088) {
        const u32x4 raw = *reinterpret_cast<const u32x4*>(zr + tlo);
        float zc[10];
        zc[0] = tlo > 0 ? bf2f(zr[tlo - 1]) : 0.f;
        zc[9] = tlo < 4088 ? bf2f(zr[tlo + 8]) : 0.f;
#pragma unroll
        for (int k = 0; k < 4; ++k) { zc[1 + 2 * k] = bfl(raw[k]); zc[2 + 2 * k] = bfh(raw[k]); }
        float vals[8];
#pragma unroll
        for (int k = 0; k < 8; ++k) vals[k] = bs + w0 * zc[k] + w1 * zc[k + 1] + w2 * zc[k + 2];
        ov = u32x4{pack2(vals[7], vals[6]), pack2(vals[5], vals[4]), pack2(vals[3], vals[2]), pack2(vals[1], vals[0])};
      }
      *reinterpret_cast<u32x4*>(UR + b * 4240 + i0) = ov;
    }
  }
  __syncthreads();
  const int bsel = wid >> 1, chalf = wid & 1;
  const int r = lane & 31, g = lane >> 5;
  const int c = chalf * 32 + r;
  for (int o = 0; o < 2; ++o) {
    const float inv = 1.f / (red[o * 2] + red[o * 2 + 1]);
    const u16* tf = taps + (size_t)(o * 512 + ch) * 4096;
    const u16* tb = taps + (size_t)(o * 512 + 256 + ch) * 4096;
    for (int ci = tid; ci < 1024; ci += 256) {
      const int i0 = ci * 8;
      float v[8];
      if (i0 >= 4096) {
        const u32x4 raw = *reinterpret_cast<const u32x4*>(tf + i0 - 4096);
#pragma unroll
        for (int k = 0; k < 4; ++k) { v[2 * k] = bfl(raw[k]); v[2 * k + 1] = bfh(raw[k]); }
      } else {
        const u32x4 raw = *reinterpret_cast<const u32x4*>(tb + 4088 - i0);
        float A[8];
#pragma unroll
        for (int k = 0; k < 4; ++k) { A[2 * k] = bfl(raw[k]); A[2 * k + 1] = bfh(raw[k]); }
        v[0] = i0 > 0 ? bf2f(tb[4096 - i0]) : 0.f;
#pragma unroll
        for (int k = 1; k < 8; ++k) v[k] = A[8 - k];
      }
      u32x4 ov = {pack2(v[0] * inv, v[1] * inv), pack2(v[2] * inv, v[3] * inv), pack2(v[4] * inv, v[5] * inv), pack2(v[6] * inv, v[7] * inv)};
      *reinterpret_cast<u32x4*>(Hs + i0 + 8 * (i0 >> 6)) = ov;
    }
    __syncthreads();
    f32x16 acc0, acc1;
#pragma unroll
    for (int i = 0; i < 16; ++i) { acc0[i] = 0.f; acc1[i] = 0.f; }
    {
      const int start0 = 63 - c + 8 * g;
      const unsigned sh = (start0 & 1) * 16;
      const unsigned* bp = (const unsigned*)(UR + bsel * 4240 + (start0 & ~1));
      for (int ks = 0; ks < 260; ++ks) {
        const unsigned* q = bp + ks * 8;
        unsigned d0 = q[0], d1 = q[1], d2 = q[2], d3 = q[3], d4 = q[4];
        u32x4 bw = {__builtin_amdgcn_alignbit(d1, d0, sh), __builtin_amdgcn_alignbit(d2, d1, sh), __builtin_amdgcn_alignbit(d3, d2, sh), __builtin_amdgcn_alignbit(d4, d3, sh)};
        bf16x8 bf = __builtin_bit_cast(bf16x8, bw);
        int x = 16 * ks + 8 * g;
        int pos0 = 72 * (r + (x >> 6)) + (x & 63);
        bf16x8 a0 = ld16(Hs + pos0);
        bf16x8 a1 = ld16(Hs + pos0 + 72 * 32);
        acc0 = mfma32(a0, bf, acc0);
        acc1 = mfma32(a1, bf, acc1);
      }
    }
    const int gcol = o == 0 ? 256 + ch : 512 + ch;
    const float w0 = cw[gcol], w1 = cw[768 + gcol], w2 = cw[1536 + gcol], bs = cb[gcol];
    const float hb = p.in(22)[(l * 2 + o) * 256 + ch];
    const u16* zg = zhT + (size_t)gcol * 16384 + 8192 + bsel * 4096;
#pragma unroll
    for (int i0 = 0; i0 < 32; i0 += 8) {
#pragma unroll
      for (int ii = 0; ii < 8; ++ii) {
        const int i = i0 + ii;
        int row = (i & 3) + 8 * ((i & 15) >> 2) + 4 * g + 32 * (i >> 4);
        int t = 64 * row + c;
        asm volatile("" : "+v"(t));
        float conv = i < 16 ? acc0[i & 15] : acc1[i & 15];
        float uv = bf2f(UR[bsel * 4240 + 4159 - t]);
        float xg = hy_zc(zg, t, 4096, w0, w1, w2, bs);
        float rv = xg * (conv + hb * uv);
        if (o == 1) {
          size_t tok = 8192 + bsel * 4096 + t;
          float gv = bf2f(ghT[(size_t)ch * 16384 + tok]);
          ybf[tok * 1024 + ch] = f2bf(rv * silu_f(gv));
        }
        if (i < 16) acc0[i & 15] = rv; else acc1[i & 15] = rv;
      }
      __builtin_amdgcn_sched_barrier(0);
    }
    __syncthreads();
    if (o == 0) {
#pragma unroll
      for (int i = 0; i < 32; ++i) {
        int row = (i & 3) + 8 * ((i & 15) >> 2) + 4 * g + 32 * (i >> 4);
        int t = 64 * row + c;
        UR[bsel * 4240 + 4159 - t] = f2bf(i < 16 ? acc0[i & 15] : acc1[i & 15]);
      }
    }
    __syncthreads();
  }
}

__device__ __forceinline__ void hyena_ctx_item(const Params& p, int l, int item, char* smem) {
  const int TIDX = opq_v(threadIdx.x);
  const int b = item >> 6, cg4 = item & 63;
  const int tid = TIDX, lane = tid & 63, wid = tid >> 6;
  const int ch = cg4 * 4 + wid;
  float* Hs = (float*)smem + wid * 1024;
  float* U = Hs + 512;
  const u16* zhT = (const u16*)(p.ws() + OFF_ZHT);
  const u16* ghT = (const u16*)(p.ws() + OFF_GHT);
  u16* ybf = (u16*)(p.ws() + OFF_HBF);
  const u16* taps = (const u16*)(p.ws() + OFF_TAPS + l * TAPS_LAYER + 8388608);
  const float* psum = (const float*)(p.ws() + OFF_PSUM + l * PSUM_LAYER) + 128 * 1024;
  const float* cw = p.in(13) + l * 3 * 768; const float* cb = p.in(14) + l * 768;
  const u16* zs = zhT + b * 256;
  float vv[4];
  {
    float w0 = cw[ch], w1 = cw[768 + ch], w2 = cw[1536 + ch], bs = cb[ch];
#pragma unroll
    for (int i = 0; i < 4; ++i) { int t = lane + 64 * i; vv[i] = hy_zc(zs + (size_t)ch * 16384, t, 256, w0, w1, w2, bs); U[t] = vv[i]; }
  }
  for (int o = 0; o < 2; ++o) {
    float s = 0.f;
    if (lane < 16) s = psum[(lane & 7) * 1024 + o * 512 + (lane >> 3) * 256 + ch];
    s = warp_sum(s);
    const float inv = 1.f / s;
    const u16* tf = taps + (size_t)(o * 512 + ch) * 256;
    const u16* tb = taps + (size_t)(o * 512 + 256 + ch) * 256;
    for (int idx = lane; idx < 512; idx += 64) {
      int off = idx - 255; float v = 0.f;
      if (idx < 511) v = off >= 0 ? bf2f(tf[off]) : bf2f(tb[-off]);
      Hs[idx] = v * inv;
    }
    __syncthreads();
    float acc[4] = {0.f, 0.f, 0.f, 0.f};
    for (int sidx = 0; sidx < 256; ++sidx) {
      float uu = U[sidx];
#pragma unroll
      for (int i = 0; i < 4; ++i) acc[i] += Hs[lane + 64 * i - sidx + 255] * uu;
    }
    const int gcol = o == 0 ? 256 + ch : 512 + ch;
    const float w0 = cw[gcol], w1 = cw[768 + gcol], w2 = cw[1536 + gcol], bs = cb[gcol];
    const float hb = p.in(22)[(l * 2 + o) * 256 + ch];
    float res[4];
#pragma unroll
    for (int i = 0; i < 4; ++i) {
      int t = lane + 64 * i;
      float xg = hy_zc(zs + (size_t)gcol * 16384, t, 256, w0, w1, w2, bs);
      res[i] = xg * (acc[i] + hb * vv[i]);
    }
    __syncthreads();
    if (o == 0) {
#pragma unroll
      for (int i = 0; i < 4; ++i) { U[lane + 64 * i] = res[i]; vv[i] = res[i]; }
    } else {
#pragma unroll
      for (int i = 0; i < 4; ++i) {
        size_t tok = b * 256 + lane + 64 * i;
        float gv = bf2f(ghT[(size_t)ch * 16384 + tok]);
        ybf[tok * 1024 + ch] = f2bf(res[i] * silu_f(gv));
      }
    }
    __syncthreads();
  }
}

__device__ __forceinline__ int s5_tokbase(int col) {
  if (col < 256) return 8192 + (col >> 7) * 4096 + 32 * (col & 127);
  return ((col - 256) >> 3) * 256 + 32 * (col & 7);
}

__device__ __forceinline__ void s5_gemm1_tile(const Params& p, int l, int tile, char* smem) {
  const int TIDX = opq_v(threadIdx.x);
  const int g = tile >> 3, m0 = ((tile >> 1) & 3) * 128, n0 = (tile & 1) * 128;
  const int lg = l * 16 + g;
  const u16* z = (const u16*)(p.ws() + OFF_Z);
  const u16* E = (const u16*)(p.ws() + OFF_S5E) + (size_t)lg * 256 * 512;
  float* Eu = (float*)(p.ws() + OFF_EU) + (size_t)g * 512 * 256;
  f32x4 acc[4][4];
#pragma unroll
  for (int a = 0; a < 4; ++a)
#pragma unroll
    for (int b = 0; b < 4; ++b) acc[a][b] = f32x4{0.f, 0.f, 0.f, 0.f};
  auto fa = [=](int r, int kt, int c) { int k = kt * 64 + c * 8; return z + (size_t)(s5_tokbase(m0 + r) + (k >> 4)) * ZW + ZS + g * 16 + (k & 8); };
  auto fb = [=](int r, int kt, int c) { return E + (size_t)(n0 + r) * 512 + kt * 64 + c * 8; };
  gemm_mainloop_g<true>(fa, fb, 8, smem, acc);
  const int lane = TIDX & 63, wid = TIDX >> 6, wm = wid >> 1, wn = wid & 1, fr = lane & 15, fq = lane >> 4;
#pragma unroll
  for (int mt = 0; mt < 4; ++mt)
#pragma unroll
    for (int nt = 0; nt < 4; ++nt) {
      int m = m0 + wm * 64 + mt * 16 + fr, n = n0 + wn * 64 + nt * 16 + fq * 4;
      f32x4 v = acc[mt][nt];
      *(float4*)(Eu + (size_t)m * 256 + n) = make_float4(v[0], v[1], v[2], v[3]);
    }
}

__device__ __forceinline__ void s5_scan_item(const Params& p, int l, int item) {
  const int TIDX = opq_v(threadIdx.x);
  const int g = item >> 2, part = item & 3;
  const float* Eu = (const float*)(p.ws() + OFF_EU) + (size_t)g * 512 * 256;
  u16* Sin = (u16*)(p.ws() + OFF_SIN) + (size_t)g * 512 * 256;
  const int tid = TIDX;
  const int nchain = part < 2 ? 128 : 2048;
  for (int e = tid; e < nchain; e += 256) {
    const int sq = e >> 7, dir = (e >> 6) & 1, pp = e & 63;
    const int base = (l * 2 + dir) * 16 + g;
    float dt = expf(p.in(26)[base]);
    float ar = p.in(24)[base * 64 + pp], ai = p.in(25)[base * 64 + pp];
    float mag = expf(ar * dt * 32.f);
    double tw = (double)(ai * dt) * 32.0 * 0.15915494309189535; tw -= floor(tw);
    float sn, cs; sincosf((float)(tw * 6.283185307179586), &sn, &cs);
    const float lr = mag * cs, li = mag * sn;
    float sr = 0.f, si = 0.f;
    int col0, nch;
    if (part < 2) {
      size_t sidx = ((size_t)((part * 2 + l) * 2 + dir) * 16 + g) * 64 + pp;
      sr = p.in(4)[sidx]; si = p.in(5)[sidx];
      col0 = part * 128; nch = 128;
    } else { col0 = 256 + (16 * (part - 2) + sq) * 8; nch = 8; }
    const int rrow = dir * 128 + pp;
    for (int c8 = 0; c8 < nch; c8 += 8) {
      float er[8], ei[8];
#pragma unroll
      for (int q = 0; q < 8; ++q) {
        const int cc = c8 + q; const int c2 = col0 + (dir == 0 ? cc : nch - 1 - cc);
        er[q] = Eu[(size_t)c2 * 256 + rrow]; ei[q] = Eu[(size_t)c2 * 256 + rrow + 64];
      }
      __builtin_amdgcn_sched_barrier(0);
#pragma unroll
      for (int q = 0; q < 8; ++q) {
        const int cc = c8 + q; const int c2 = col0 + (dir == 0 ? cc : nch - 1 - cc);
        Sin[(size_t)c2 * 256 + rrow] = f2bf(sr); Sin[(size_t)c2 * 256 + rrow + 64] = f2bf(si);
        float nr = lr * sr - li * si + er[q], ni = lr * si + li * sr + ei[q];
        sr = nr; si = ni;
      }
    }
    if (part >= 2) {
      int bq = 16 * (part - 2) + sq;
      size_t oidx = ((size_t)((bq * 2 + l) * 2 + dir) * 16 + g) * 64 + pp;
      p.out()[OUT_SRE + oidx] = sr; p.out()[OUT_SIM + oidx] = si;
    }
  }
}

__device__ __forceinline__ void s5_gemm3_tile(const Params& p, int l, int tile, char* smem) {
  const int TIDX = opq_v(threadIdx.x);
  const int g = tile >> 4, m0 = ((tile >> 2) & 3) * 128, n0 = (tile & 3) * 128;
  const int lg = l * 16 + g;
  const u16* z = (const u16*)(p.ws() + OFF_Z);
  const u16* G = (const u16*)(p.ws() + OFF_S5G) + (size_t)lg * 512 * 256;
  const u16* KKc = (const u16*)(p.ws() + OFF_S5KK) + (size_t)lg * 2 * 8192;
  const u16* Sin = (const u16*)(p.ws() + OFF_SIN) + (size_t)g * 512 * 256;
  u16* yg = (u16*)(p.ws() + OFF_YG);
  f32x4 acc[4][4];
#pragma unroll
  for (int a = 0; a < 4; ++a)
#pragma unroll
    for (int b = 0; b < 4; ++b) acc[a][b] = f32x4{0.f, 0.f, 0.f, 0.f};
  auto fa = [=](int r, int kt, int c) {
    if (kt < 8) { int k = kt * 64 + c * 8; return z + (size_t)(s5_tokbase(m0 + r) + (k >> 4)) * ZW + ZS + g * 16 + (k & 8); }
    return Sin + (size_t)(m0 + r) * 256 + (kt - 8) * 64 + c * 8;
  };
  auto fb = [=](int r, int kt, int c) {
    const int n = n0 + r;
    if (kt < 8) { int k = kt * 64 + c * 8; int j = k >> 4; return KKc + (size_t)((n >> 4) - j + 31) * 256 + (n & 15) * 16 + (k & 8); }
    return G + (size_t)n * 256 + (kt - 8) * 64 + c * 8;
  };
  gemm_mainloop_g<true>(fa, fb, 12, smem, acc);
  const int lane = TIDX & 63, wid = TIDX >> 6, wm = wid >> 1, wn = wid & 1, fr = lane & 15, fq = lane >> 4;
  const float* dsk = p.in(31) + l * 256 + g * 16;
#pragma unroll
  for (int mt = 0; mt < 4; ++mt) {
    const int col = m0 + wm * 64 + mt * 16 + fr;
    const int tb = s5_tokbase(col);
#pragma unroll
    for (int nt = 0; nt < 4; ++nt) {
      const int n = n0 + wn * 64 + nt * 16 + fq * 4;
      const int i = n >> 4, c0 = n & 15;
      const size_t tok = tb + i;
      u32x2 uu = *reinterpret_cast<const u32x2*>(z + tok * ZW + ZS + g * 16 + c0);
      float uvals[4] = {bfl(uu[0]), bfh(uu[0]), bfl(uu[1]), bfh(uu[1])};
      float o[4];
#pragma unroll
      for (int e = 0; e < 4; ++e) {
        float y = acc[mt][nt][e] + dsk[c0 + e] * uvals[e];
        float t3 = 0.7978845608028654f * (y + 0.044715f * y * y * y);
        o[e] = 0.5f * y * (1.f + tanhf(t3));
      }
      u32x2 ov = {pack2(o[0], o[1]), pack2(o[2], o[3])};
      *reinterpret_cast<u32x2*>(yg + tok * 256 + g * 16 + c0) = ov;
    }
  }
}

__device__ __forceinline__ void glu_item(const Params& p, int l, int item) {
  const int TIDX = opq_v(threadIdx.x);
  const u16* yg = (const u16*)(p.ws() + OFF_YG);
  const u16* gT = (const u16*)(p.ws() + OFF_GLUT) + (size_t)l * 65536;
  const u16* z = (const u16*)(p.ws() + OFF_Z);
  u16* ybf = (u16*)(p.ws() + OFF_HBF);
  const float* gb = p.in(33) + l * 256;
  const int lane = TIDX & 63, wid = TIDX >> 6, r = lane & 31, h = lane >> 5;
  const int tok = item * 32 + r;
  f32x16 acc[2];
#pragma unroll
  for (int a = 0; a < 2; ++a)
#pragma unroll
    for (int i = 0; i < 16; ++i) acc[a][i] = 0.f;
  for (int ks = 0; ks < 16; ++ks) {
    bf16x8 yf = ld16(yg + (size_t)tok * 256 + ks * 16 + 8 * h);
#pragma unroll
    for (int rt = 0; rt < 2; ++rt) {
      bf16x8 wf = ld16(gT + (size_t)(wid * 64 + rt * 32 + r) * 256 + ks * 16 + 8 * h);
      acc[rt] = mfma32(wf, yf, acc[rt]);
    }
  }
#pragma unroll
  for (int rt = 0; rt < 2; ++rt)
#pragma unroll
    for (int q = 0; q < 4; ++q) {
      int n0 = wid * 64 + rt * 32 + 8 * q + 4 * h;
      u32x2 yy = *reinterpret_cast<const u32x2*>(yg + (size_t)tok * 256 + n0);
      u32x2 gg = *reinterpret_cast<const u32x2*>(z + (size_t)tok * ZW + ZG + 768 + n0);
      float yv[4] = {bfl(yy[0]), bfh(yy[0]), bfl(yy[1]), bfh(yy[1])};
      float gv[4] = {bfl(gg[0]), bfh(gg[0]), bfl(gg[1]), bfh(gg[1])};
      float o[4];
#pragma unroll
      for (int e = 0; e < 4; ++e) {
        float v = acc[rt][4 * q + e] + gb[n0 + e];
        o[e] = yv[e] / (1.f + __expf(-v)) * silu_f(gv[e]);
      }
      u32x2 ov = {pack2(o[0], o[1]), pack2(o[2], o[3])};
      *reinterpret_cast<u32x2*>(ybf + (size_t)tok * 1024 + 768 + n0) = ov;
    }
}

template <int SUB>
__device__ __forceinline__ void phase_mixers(const Params& p, int l, char* smem) {
  const int NA = SUB == 0 ? 256 * REP_HL : (SUB == 1 ? 64 * REP_S5 : 256 * REP_S5);
  const int NB = SUB == 0 ? 128 * REP_S5 : (SUB == 1 ? 512 * REP_AL : 256 * REP_AC);
  const int NC = SUB == 2 ? 2048 * REP_HC : 0;
  const int total = NA + NB + NC;
  unsigned* ctr = (unsigned*)(p.ws() + OFF_CTR) + 64 * (l * 3 + SUB);
  for (;;) {
    int i = next_item(ctr, smem);
    if (i >= total) break;
    const int lq = opq_s(l);
    Params q; q.tab = (const unsigned long long*)(smem + opq_s(LDS_BYTES));
    if (SUB == 0) {
      if (i < NA) { hyena_lat_item(q, lq, i % 256, smem); continue; }
      s5_gemm1_tile(q, lq, (i - NA) % 128, smem);
    } else if (SUB == 1) {
      if (i < NA) { s5_scan_item(q, lq, i % 64); continue; }
      attn_lat_item(q, lq, (i - NA) % 512, smem);
    } else {
      if (i < NA) { s5_gemm3_tile(q, lq, i % 256, smem); continue; }
      i -= NA;
      if (i < NB) { attn_ctx_item(q, i % 256); continue; }
      hyena_ctx_item(q, lq, (i - NB) % 2048, smem);
    }
  }
}

__global__ void __launch_bounds__(256, 2) __attribute__((amdgpu_waves_per_eu(2, 2))) fwd_megakernel(KArgs ka) {
  __shared__ __attribute__((aligned(16))) char smem[LDS_BYTES + 512];
  cg::grid_group grid = cg::this_grid();
  {
    unsigned long long* t = (unsigned long long*)(smem + LDS_BYTES);
    if (threadIdx.x == 0) {
#pragma unroll
      for (int i = 0; i < 35; ++i) t[i] = (unsigned long long)ka.in[i];
      t[35] = (unsigned long long)ka.out; t[36] = (unsigned long long)ka.ws;
    }
    __syncthreads();
  }
  Params p; p.tab = (const unsigned long long*)(smem + LDS_BYTES);
  for (int rep = 1; rep < REP_P0; ++rep) { phase0(p, (float*)smem); grid.sync(); }
  phase0(p, (float*)smem);
  grid.sync();
  volatile LAS unsigned* xst = (volatile LAS unsigned*)(smem + LDS_BYTES + 480);
  if (threadIdx.x == 0) { xst[0] = 0u; xst[1] = 0u; }
  __syncthreads();
  XcdBarrier xb = xcd_barrier_post((unsigned*)(p.ws() + OFF_BAR), xst);
#pragma unroll 1
  for (int l0 = 0; l0 < 2; ++l0) {
    const int l = opq_s(l0);
    phase_prenorm(p, l);
    xcd_barrier(xb);
    for (int rep = 1; rep < REP_GIN; ++rep) { phase_gemm_in(p, l, smem); xcd_barrier(xb); }
    phase_gemm_in(p, l, smem);
    xcd_barrier(xb);
    phase_mixers<0>(p, l, smem);
    xcd_barrier(xb);
    phase_mixers<1>(p, l, smem);
    xcd_barrier(xb);
    phase_mixers<2>(p, l, smem);
    xcd_barrier(xb);
    for (int it = blockIdx.x; it < 512; it += gridDim.x) glu_item(p, l, it);
    xcd_barrier(xb);
    for (int rep = 1; rep < REP_GOUT; ++rep) { if (l == 0) { phase_gemm_out(p, l, smem); xcd_barrier(xb); } }
    phase_gemm_out(p, l, smem);
    xcd_barrier(xb);
  }
  phase_finalnorm(p);
}

extern "C" void kernel_launch(void* const* d_in, const int* in_sizes, int n_in, void* d_out, int out_size, void* d_ws, size_t ws_size, hipStream_t stream) {
  static int grid_blocks = 0;
  if (!grid_blocks) {
    int dev = 0, cus = 0, per_cu = 0;
    hipGetDevice(&dev);
    hipDeviceGetAttribute(&cus, hipDeviceAttributeMultiprocessorCount, dev);
    hipOccupancyMaxActiveBlocksPerMultiprocessor(&per_cu, fwd_megakernel, 256, 0);
    if (per_cu > 4) per_cu = 4;
    grid_blocks = cus * per_cu;
  }
  KArgs p{};
  for (int i = 0; i < 35; ++i) p.in[i] = (const float*)d_in[i];
  p.out = (float*)d_out;
  p.ws = (char*)d_ws;
  void* args[] = {&p};
  hipError_t e = hipLaunchCooperativeKernel((void*)fwd_megakernel, dim3(grid_blocks), dim3(256), args, 0, stream);
  if (e != hipSuccess) fprintf(stderr, "cooperative launch failed: %s (grid %d)\n", hipGetErrorString(e), grid_blocks);
}
```
